# Optimizing an MI355X kernel written in HIP

```python
import math
import jax, jax.numpy as jnp
from jax import lax
import numpy as np

D_MODEL = 1024
BATCH = 4
SEQ = 8192
DEPTH = 2

CHUNK = 64
D_MIX = D_MODEL
EPS = 1e-6

A_HEADS = 4
A_HEAD_DIM = 64
A_LEFT_CHUNKS = 8
A_BAND = (A_LEFT_CHUNKS + 1) * CHUNK
REL_PAST = 256
REL_FUTURE = CHUNK - 1
N_REL = REL_PAST + REL_FUTURE + 1

B_HEADS = 4
B_HEAD_DIM = 64
Q_BLOCK = 128
FGATE_BIAS_OFFSET = 2.0

C_HEADS = 4
C_HEAD_DIM = 128
C_CONV = 4

D_FF = 2816
FFN_CONV = 3

A_W = A_HEADS * A_HEAD_DIM
B_W = B_HEADS * B_HEAD_DIM
C_W = C_HEADS * C_HEAD_DIM

A_QKV_END = 3 * A_W
B_QKV_END = A_QKV_END + 3 * B_W
B_F_END = B_QKV_END + B_HEADS
C_QKV_END = B_F_END + 3 * C_W
C_BETA_END = C_QKV_END + C_HEADS
C_A_END = C_BETA_END + C_HEADS
D_IN = C_A_END + C_W
SPLIT_POINTS = (A_QKV_END, B_QKV_END, B_F_END, C_QKV_END, C_BETA_END, C_A_END)

kernel_name = "hybrid_chunk_stream_encoder"


def rms_norm(x, g):
    xf = x.astype(jnp.float32)
    y = xf * lax.rsqrt(jnp.mean(xf * xf, axis=-1, keepdims=True) + EPS)
    return (y * g.astype(jnp.float32)).astype(x.dtype)


def l2_normalize(x):
    return x * lax.rsqrt(jnp.sum(x * x, axis=-1, keepdims=True) + EPS)


def causal_dwconv(x, w):
    K = w.shape[0]
    T = x.shape[1]
    xp = jnp.pad(x, ((0, 0), (K - 1, 0), (0, 0)))
    return sum(xp[:, i:i + T] * w[i] for i in range(K))


def chunk_relpos_attention(q, k, v, rel_table):
    Bsz, T, H, Dh = q.shape
    nC = T // CHUNK
    qc = q.reshape(Bsz, nC, CHUNK, H, Dh)
    pad = ((0, 0), (A_LEFT_CHUNKS, 0), (0, 0), (0, 0), (0, 0))
    kc = jnp.pad(k.reshape(Bsz, nC, CHUNK, H, Dh), pad)
    vc = jnp.pad(v.reshape(Bsz, nC, CHUNK, H, Dh), pad)
    kb = jnp.concatenate([kc[:, j:j + nC] for j in range(A_LEFT_CHUNKS + 1)], axis=2)
    vb = jnp.concatenate([vc[:, j:j + nC] for j in range(A_LEFT_CHUNKS + 1)], axis=2)
    s = jnp.einsum('bnqhd,bnkhd->bhnqk', qc, kb,
                   preferred_element_type=jnp.float32) * (Dh ** -0.5)
    qi = jnp.arange(CHUNK)[:, None]
    kk = jnp.arange(A_BAND)[None, :]
    rel = qi - (kk - A_LEFT_CHUNKS * CHUNK)
    idx = jnp.clip(rel, -REL_FUTURE, REL_PAST) + REL_FUTURE
    bias = rel_table.astype(jnp.float32)[:, idx]
    s = s + bias[None, :, None, :, :]
    chunk_id = jnp.arange(nC)[:, None]
    slot = (jnp.arange(A_BAND) // CHUNK)[None, :]
    valid = (chunk_id + slot - A_LEFT_CHUNKS) >= 0
    s = jnp.where(valid[None, None, :, None, :], s, -jnp.inf)
    p = jax.nn.softmax(s, axis=-1)
    o = jnp.einsum('bhnqk,bnkhd->bnqhd', p.astype(v.dtype), vb)
    return o.reshape(Bsz, T, H * Dh)


def forgetting_attention(q, k, v, f_logit):
    Bsz, T, H, Dh = q.shape
    logf = jax.nn.log_sigmoid(f_logit.astype(jnp.float32))
    F = jnp.cumsum(logf, axis=1)
    Fk = F.transpose(0, 2, 1)
    nQ = T // Q_BLOCK
    qb = q.reshape(Bsz, nQ, Q_BLOCK, H, Dh).transpose(1, 0, 2, 3, 4)
    Fq = F.reshape(Bsz, nQ, Q_BLOCK, H).transpose(1, 0, 3, 2)
    kpos = jnp.arange(T)
    scale = Dh ** -0.5

    def block(args):
        q_i, Fq_i, i = args
        s = jnp.einsum('bqhd,bkhd->bhqk', q_i, k,
                       preferred_element_type=jnp.float32) * scale
        s = s + Fq_i[:, :, :, None] - Fk[:, :, None, :]
        qpos = i * Q_BLOCK + jnp.arange(Q_BLOCK)
        s = jnp.where(kpos[None, :] <= qpos[:, None], s, -jnp.inf)
        p = jax.nn.softmax(s, axis=-1)
        return jnp.einsum('bhqk,bkhd->bqhd', p.astype(v.dtype), v)

    o = lax.map(block, (qb, Fq, jnp.arange(nQ)))
    return o.transpose(1, 0, 2, 3, 4).reshape(Bsz, T, H * Dh)


def gated_deltanet(q, k, v, beta_logit, a_logit, A_log, dt_bias):
    f32 = jnp.float32
    Bsz, T, H, Dk = q.shape
    Dv = v.shape[-1]
    nC = T // CHUNK
    q = l2_normalize(q.astype(f32)) * (Dk ** -0.5)
    k = l2_normalize(k.astype(f32))
    v = v.astype(f32)
    beta = jax.nn.sigmoid(beta_logit.astype(f32))
    g = -jnp.exp(A_log.astype(f32)) * jax.nn.softplus(a_logit.astype(f32) + dt_bias.astype(f32))

    def to_chunks(t):
        return t.reshape(Bsz, nC, CHUNK, H, -1).transpose(0, 3, 1, 2, 4)

    def to_chunks_h(t):
        return t.reshape(Bsz, nC, CHUNK, H).transpose(0, 3, 1, 2)

    qc, kc, vc = to_chunks(q), to_chunks(k), to_chunks(v)
    bc = to_chunks_h(beta)
    gc = jnp.cumsum(to_chunks_h(g), axis=-1)
    kbeta = kc * bc[..., None]
    vbeta = vc * bc[..., None]
    tril = jnp.tril(jnp.ones((CHUNK, CHUNK), dtype=bool))
    strict = jnp.tril(jnp.ones((CHUNK, CHUNK), dtype=bool), k=-1)
    diff = gc[..., :, None] - gc[..., None, :]
    Lm = jnp.where(tril, jnp.exp(jnp.where(tril, diff, 0.0)), 0.0)
    Amat = jnp.where(strict, jnp.einsum('bhncd,bhnsd->bhncs', kbeta, kc) * Lm, 0.0)
    eye = jnp.eye(CHUNK, dtype=f32)
    rhs = jnp.concatenate([vbeta, kbeta * jnp.exp(gc)[..., None]], axis=-1)
    sol = lax.linalg.triangular_solve(eye + Amat, rhs, left_side=True, lower=True,
                                      unit_diagonal=True)
    U, W = sol[..., :Dv], sol[..., Dv:]
    attn = jnp.where(tril, jnp.einsum('bhncd,bhnsd->bhncs', qc, kc) * Lm, 0.0)

    def step(S, inp):
        q_i, k_i, u_i, w_i, g_i, a_i = inp
        v_new = u_i - jnp.einsum('bhck,bhkv->bhcv', w_i, S)
        o = (jnp.einsum('bhck,bhkv->bhcv', q_i * jnp.exp(g_i)[..., None], S)
             + jnp.einsum('bhcs,bhsv->bhcv', a_i, v_new))
        g_last = g_i[..., -1]
        k_dec = k_i * jnp.exp(g_last[..., None] - g_i)[..., None]
        S = S * jnp.exp(g_last)[..., None, None] + jnp.einsum('bhck,bhcv->bhkv', k_dec, v_new)
        return S, o

    xs = tuple(jnp.moveaxis(t, 2, 0) for t in (qc, kc, U, W, gc, attn))
    S0 = jnp.zeros((Bsz, H, Dk, Dv), f32)
    _, o = lax.scan(step, S0, xs)
    return o.transpose(1, 0, 3, 2, 4).reshape(Bsz, T, H, Dv)


def hybrid_mixer(h, w_in, w_out, rel_bias, fgate_bias, conv_w, A_log, dt_bias, gnorm_g):
    Bsz, T, _ = h.shape
    proj = h @ w_in
    qkv_a, qkv_b, f_logit, qkv_c, beta_logit, a_logit, z = jnp.split(proj, SPLIT_POINTS, axis=-1)
    qa, ka, va = [t.reshape(Bsz, T, A_HEADS, A_HEAD_DIM) for t in jnp.split(qkv_a, 3, axis=-1)]
    o_a = chunk_relpos_attention(qa, ka, va, rel_bias)
    qb, kb, vb = [t.reshape(Bsz, T, B_HEADS, B_HEAD_DIM) for t in jnp.split(qkv_b, 3, axis=-1)]
    o_b = forgetting_attention(qb, kb, vb, f_logit + fgate_bias)
    qkv_c = jax.nn.silu(causal_dwconv(qkv_c, conv_w))
    qc, kc, vc = [t.reshape(Bsz, T, C_HEADS, C_HEAD_DIM) for t in jnp.split(qkv_c, 3, axis=-1)]
    o_c = gated_deltanet(qc, kc, vc, beta_logit, a_logit, A_log, dt_bias)
    zc = z.reshape(Bsz, T, C_HEADS, C_HEAD_DIM).astype(jnp.float32)
    o_c = (rms_norm(o_c, gnorm_g) * jax.nn.silu(zc)).astype(h.dtype).reshape(Bsz, T, C_W)
    return jnp.concatenate([o_a, o_b, o_c], axis=-1) @ w_out


def conv_gated_mlp(h, w_up, conv_w, w_down):
    u = causal_dwconv(h @ w_up, conv_w)
    gate, up = jnp.split(u, 2, axis=-1)
    return (jax.nn.silu(gate) * up) @ w_down


def setup_inputs(seed: int = 0) -> dict:
    key = jax.random.key(seed)
    ks = jax.random.split(key, 20)
    f32 = jnp.float32
    nrm = lambda k, shape, s: jax.random.normal(k, shape, f32) * s
    x = nrm(ks[0], (BATCH, SEQ, D_MODEL), 1.0)
    c = nrm(ks[1], (BATCH, D_MODEL), 1.0)
    ada_w = nrm(ks[2], (DEPTH, D_MODEL, 6 * D_MODEL), 0.5 * D_MODEL ** -0.5)
    ada_b = nrm(ks[3], (DEPTH, 6 * D_MODEL), 0.02)
    norm_mix_g = 1.0 + nrm(ks[4], (DEPTH, D_MODEL), 0.02)
    norm_ffn_g = 1.0 + nrm(ks[5], (DEPTH, D_MODEL), 0.02)
    w_in = nrm(ks[6], (DEPTH, D_MODEL, D_IN), D_MODEL ** -0.5)
    w_out = nrm(ks[7], (DEPTH, D_MIX, D_MODEL), D_MIX ** -0.5)
    rel_bias = nrm(ks[8], (DEPTH, A_HEADS, N_REL), 0.5)
    fgate_bias = FGATE_BIAS_OFFSET + nrm(ks[9], (DEPTH, B_HEADS), 0.5)
    gdn_conv_w = nrm(ks[10], (DEPTH, C_CONV, 3 * C_W), C_CONV ** -0.5)
    gdn_A_log = jnp.log(jax.random.uniform(ks[11], (DEPTH, C_HEADS), f32, 1.0, 16.0))
    dt = jnp.exp(jax.random.uniform(ks[12], (DEPTH, C_HEADS), f32,
                                    math.log(1e-3), math.log(1e-1)))
    gdn_dt_bias = dt + jnp.log(-jnp.expm1(-dt))
    gdn_norm_g = 1.0 + nrm(ks[13], (DEPTH, C_HEAD_DIM), 0.02)
    ffn_w_up = nrm(ks[14], (DEPTH, D_MODEL, 2 * D_FF), D_MODEL ** -0.5)
    ffn_conv_w = nrm(ks[15], (DEPTH, FFN_CONV, 2 * D_FF), FFN_CONV ** -0.5)
    ffn_w_down = nrm(ks[16], (DEPTH, D_FF, D_MODEL), D_FF ** -0.5)
    final_norm_g = 1.0 + nrm(ks[17], (D_MODEL,), 0.02)
    return {"x": x, "c": c, "ada_w": ada_w, "ada_b": ada_b,
            "norm_mix_g": norm_mix_g, "norm_ffn_g": norm_ffn_g,
            "w_in": w_in, "w_out": w_out, "rel_bias": rel_bias, "fgate_bias": fgate_bias,
            "gdn_conv_w": gdn_conv_w, "gdn_A_log": gdn_A_log, "gdn_dt_bias": gdn_dt_bias,
            "gdn_norm_g": gdn_norm_g, "ffn_w_up": ffn_w_up, "ffn_conv_w": ffn_conv_w,
            "ffn_w_down": ffn_w_down, "final_norm_g": final_norm_g}


def reference(x, c, ada_w, ada_b, norm_mix_g, norm_ffn_g, w_in, w_out, rel_bias, fgate_bias,
              gdn_conv_w, gdn_A_log, gdn_dt_bias, gdn_norm_g, ffn_w_up, ffn_conv_w,
              ffn_w_down, final_norm_g):
    c_act = jax.nn.silu(c)
    for l in range(DEPTH):
        mod = (c_act @ ada_w[l] + ada_b[l])[:, None, :]
        shift1, scale1, gate1, shift2, scale2, gate2 = jnp.split(mod, 6, axis=-1)
        h = rms_norm(x, norm_mix_g[l]) * (1.0 + scale1) + shift1
        x = x + gate1 * hybrid_mixer(h, w_in[l], w_out[l], rel_bias[l], fgate_bias[l],
                                     gdn_conv_w[l], gdn_A_log[l], gdn_dt_bias[l], gdn_norm_g[l])
        h = rms_norm(x, norm_ffn_g[l]) * (1.0 + scale2) + shift2
        x = x + gate2 * conv_gated_mlp(h, ffn_w_up[l], ffn_conv_w[l], ffn_w_down[l])
    return rms_norm(x, final_norm_g)
```

```cpp
#include <hip/hip_runtime.h>
#include <hip/hip_cooperative_groups.h>
#include <cstdio>
#include <cstdint>
namespace cg = cooperative_groups;
__device__ __forceinline__ int my_tid() { int t = (int)threadIdx.x; asm volatile("" : "+v"(t)); return t; }
__device__ __forceinline__ int my_bid() { int t = (int)blockIdx.x; asm volatile("" : "+s"(t)); return t; }
__device__ __forceinline__ int my_gdim() { int t = (int)gridDim.x; asm volatile("" : "+s"(t)); return t; }
namespace pg8 {
#define PG8_LAS __attribute__((address_space(3)))
typedef unsigned short bf16_t;
typedef short bf16x8 __attribute__((ext_vector_type(8)));
typedef float f32x4 __attribute__((ext_vector_type(4)));
typedef unsigned u32x4 __attribute__((ext_vector_type(4)));
constexpr int BM = 256, BK = 64, HALF = 128, HTB = HALF * BK * 2  , STAGE_BYTES = 8 * HTB, NXCD = 8, WGM = 8;

__host__ __device__ __forceinline__ int lds_byte(int r, int c) { const int st = (r >> 4) * 2 + (c >> 5), rr = r & 15, cc = c & 31, ob = rr * 64 + cc * 2; return st * 1024 + (ob ^ (((ob >> 9) & 1) << 5)); }
__host__ __device__ __forceinline__ void stage_rc(int b, int& R, int& C) { const int st = b / 1024, sb = b % 1024, swz = sb ^ (((sb >> 9) & 1) << 5); R = (st >> 1) * 16 + swz / 64; C = (st & 1) * 32 + (swz % 64) / 2; }
__host__ __device__ __forceinline__ int perm32(int rho) { const int n = rho >> 4, i = rho & 15; return 8 * (i >> 2) + 4 * n + (i & 3); }

struct Unit { int pm, pn; };
struct Gemm { const bf16_t* A; const bf16_t* Bt; int M, N, K; };

struct StaticOrder {
    int nM, nN, nwg, G, c;
    __host__ __device__ void init(int M, int N, int G_, int c_) { nM = M / BM; nN = N / BM; nwg = nM * nN; G = G_; c = c_; }
    __host__ __device__ bool next(int i, Unit& u) const {
        const long L = (long)i * G + c; if (L >= nwg) return false;
        int wgid = (int)L; { const int q = nwg / NXCD, r = nwg % NXCD, xcd = wgid % NXCD, off = wgid / NXCD; wgid = (xcd < r ? xcd * (q + 1) : r * (q + 1) + (xcd - r) * q) + off; }
        const int nig = WGM * nN, gid = wgid / nig, fm = gid * WGM, gsz = (nM - fm) < WGM ? (nM - fm) : WGM;
        u.pm = fm + ((wgid % nig) % gsz); u.pn = (wgid % nig) / gsz; return true;
    }
    __device__ __forceinline__ void a_ready(const Unit&) const {}
    __device__ __forceinline__ void done(const Unit&) const {}
};
__device__ __forceinline__ unsigned cvt_pk_bf16(float lo, float hi) { unsigned r; asm volatile("v_cvt_pk_bf16_f32 %0, %1, %2" : "=v"(r) : "v"(lo), "v"(hi)); return r; }
template <class Epi, class Sched, bool ALIGN_EPI = false, bool SP2 = false>
__device__ __forceinline__ void gemm_phase(PG8_LAS unsigned char* lds, const Gemm g, const Sched& S, const Epi& E) {
    const int tid = my_tid(), wid = __builtin_amdgcn_readfirstlane(tid >> 6), lane = tid & 63, wr = wid >> 2, wc = wid & 3, fr = lane & 15, fq = lane >> 4;
    const int K = g.K, nt = K / BK;
    unsigned voffA[2], voffB[2];
#pragma unroll
    for (int i = 0; i < 2; ++i) { int R, C; stage_rc(tid * 16 + i * 8192, R, C); const int Rb = Epi::PERM ? ((R & ~31) + perm32(R & 31)) : R;
        voffA[i] = (unsigned)(R * K + C) * 2u; voffB[i] = (unsigned)(Rb * K + C) * 2u; }
    const size_t kstep = (size_t)(BK * 2);
    const size_t hstep = (size_t)HALF * K * 2;
    const size_t tstep = 2 * hstep;
    const unsigned ldsw = (unsigned)wid * 1024u;
    const int aoff = lds_byte(wr * 64 + fr, fq * 8), boff = lds_byte(wc * 32 + fr, fq * 8);
#define PG8_SA(b, h) (((b) * 2 + (h)) * HTB)
#define PG8_SB(b, h) ((4 + (b) * 2 + (h)) * HTB)
#define PG8_STAGE(bufoff, gbase, voff) do { _Pragma("unroll") for (int _i = 0; _i < 2; ++_i) \
        __builtin_amdgcn_global_load_lds((const unsigned*)((const char*)(gbase) + (voff)[_i]), (PG8_LAS unsigned*)(lds + (bufoff) + ldsw + _i * 8192), 16, 0, 0); } while (0)
#define PG8_LDA(dst, b, h) do { _Pragma("unroll") for (int m = 0; m < 4; ++m) _Pragma("unroll") for (int k = 0; k < 2; ++k) dst[m][k] = *(const PG8_LAS bf16x8*)(lds + PG8_SA(b, h) + aoff + m * 2048 + k * 1024); } while (0)
#define PG8_LDB(dst, b, h) do { _Pragma("unroll") for (int n = 0; n < 2; ++n) _Pragma("unroll") for (int k = 0; k < 2; ++k) dst[n][k] = *(const PG8_LAS bf16x8*)(lds + PG8_SB(b, h) + boff + n * 2048 + k * 1024); } while (0)
#define PG8_MMA(ai, bj, At, Bt) do { __builtin_amdgcn_s_setprio(1); _Pragma("unroll") for (int m = 0; m < 4; ++m) _Pragma("unroll") for (int n = 0; n < 2; ++n) _Pragma("unroll") for (int k = 0; k < 2; ++k) \
        acc[ai][bj][m][n] = __builtin_amdgcn_mfma_f32_16x16x32_bf16(Bt[n][k], At[m][k], acc[ai][bj][m][n], 0, 0, 0); __builtin_amdgcn_s_setprio(0); } while (0)
#define PG8_WAIT_V(n) asm volatile("s_waitcnt vmcnt(" #n ")" ::: "memory")
#define PG8_WAIT_L(n) asm volatile("s_waitcnt lgkmcnt(" #n ")" ::: "memory")
#define PG8_BAR __builtin_amdgcn_s_barrier()
#define PG8_SCHED __builtin_amdgcn_sched_barrier(0)
    Unit cur, nxt; int ui = 0;
    if (!S.next(0, cur)) return;
    f32x4 acc[2][2][4][2];
#pragma unroll
    for (int a = 0; a < 2; ++a)
#pragma unroll
        for (int b = 0; b < 2; ++b)
#pragma unroll
            for (int m = 0; m < 4; ++m)
#pragma unroll
                for (int n = 0; n < 2; ++n) acc[a][b][m][n] = (f32x4){0.f, 0.f, 0.f, 0.f};
    bf16x8 At[4][2], B0[2][2], B1[2][2];
    const char* cA = (const char*)g.A + (size_t)cur.pm * tstep; const char* cB = (const char*)g.Bt + (size_t)cur.pn * tstep;
    S.a_ready(cur);
    if constexpr (SP2) {
        PG8_STAGE(PG8_SB(0, 0), cB, voffB); PG8_STAGE(PG8_SB(0, 1), cB + hstep, voffB); PG8_STAGE(PG8_SA(0, 0), cA, voffA); PG8_STAGE(PG8_SA(0, 1), cA + hstep, voffA);
        if (wr == 1) PG8_BAR;
        PG8_WAIT_V(2); PG8_BAR;
        PG8_STAGE(PG8_SB(1, 0), cB + kstep, voffB); PG8_STAGE(PG8_SA(1, 0), cA + kstep, voffA); PG8_STAGE(PG8_SB(1, 1), cB + hstep + kstep, voffB);
        PG8_WAIT_V(6); PG8_BAR;
    } else {
        PG8_STAGE(PG8_SB(0, 0), cB, voffB); PG8_STAGE(PG8_SA(0, 0), cA, voffA); PG8_STAGE(PG8_SB(0, 1), cB + hstep, voffB); PG8_STAGE(PG8_SA(0, 1), cA + hstep, voffA);
        if (wr == 1) PG8_BAR;
        PG8_WAIT_V(4); PG8_BAR;
        PG8_STAGE(PG8_SB(1, 0), cB + kstep, voffB); PG8_STAGE(PG8_SA(1, 0), cA + kstep, voffA); PG8_STAGE(PG8_SB(1, 1), cB + hstep + kstep, voffB);
        PG8_WAIT_V(6); PG8_BAR;
    }
    for (;;) {
        const bool has_next = S.next(ui + 1, nxt);
        const char* nA = has_next ? (const char*)g.A + (size_t)nxt.pm * tstep : cA; const char* nB = has_next ? (const char*)g.Bt + (size_t)nxt.pn * tstep : cB;
        for (int t = 0; t < nt; t += 2) {
            const bool last = (t == nt - 2);
            const char* a1 = cA + (size_t)(t + 1) * kstep;
            const char* a2 = last ? nA : cA + (size_t)(t + 2) * kstep; const char* b2 = last ? nB : cB + (size_t)(t + 2) * kstep;
            const char* a3 = a2 + kstep; const char* b3 = b2 + kstep;
            if (last && has_next) S.a_ready(nxt);
            if constexpr (SP2) {
            PG8_LDB(B0, 0, 0); PG8_LDB(B1, 0, 1); PG8_SCHED; PG8_LDA(At, 0, 0); PG8_STAGE(PG8_SA(1, 1), a1 + hstep, voffA);
            PG8_WAIT_V(8); PG8_WAIT_L(0); PG8_BAR; PG8_MMA(0, 0, At, B0); PG8_MMA(0, 1, At, B1); PG8_BAR; PG8_SCHED;
            PG8_LDA(At, 0, 1); PG8_STAGE(PG8_SB(0, 0), b2, voffB); PG8_STAGE(PG8_SB(0, 1), b2 + hstep, voffB); PG8_STAGE(PG8_SA(0, 0), a2, voffA);
            PG8_WAIT_V(8); PG8_WAIT_L(0); PG8_BAR; PG8_MMA(1, 0, At, B0); PG8_MMA(1, 1, At, B1); PG8_BAR; PG8_SCHED;
            PG8_LDB(B0, 1, 0); PG8_LDB(B1, 1, 1); PG8_SCHED; PG8_LDA(At, 1, 0); PG8_STAGE(PG8_SA(0, 1), a2 + hstep, voffA);
            PG8_WAIT_V(8); PG8_WAIT_L(0); PG8_BAR; PG8_MMA(0, 0, At, B0); PG8_MMA(0, 1, At, B1); PG8_BAR; PG8_SCHED;
            PG8_LDA(At, 1, 1); PG8_STAGE(PG8_SB(1, 0), b3, voffB); PG8_STAGE(PG8_SB(1, 1), b3 + hstep, voffB); PG8_STAGE(PG8_SA(1, 0), a3, voffA);
            PG8_WAIT_V(8); PG8_WAIT_L(0); PG8_BAR; PG8_MMA(1, 0, At, B0); PG8_MMA(1, 1, At, B1); PG8_BAR; PG8_SCHED;
            } else {
            PG8_LDB(B0, 0, 0); PG8_SCHED; PG8_LDA(At, 0, 0); PG8_STAGE(PG8_SA(1, 1), a1 + hstep, voffA);
            PG8_WAIT_L(8); PG8_BAR; PG8_WAIT_L(0); PG8_MMA(0, 0, At, B0); PG8_BAR; PG8_SCHED;
            PG8_LDB(B1, 0, 1); PG8_STAGE(PG8_SB(0, 0), b2, voffB);
            PG8_BAR; PG8_WAIT_L(0); PG8_MMA(0, 1, At, B1); PG8_BAR;
            PG8_LDA(At, 0, 1); PG8_STAGE(PG8_SA(0, 0), a2, voffA);
            PG8_BAR; PG8_WAIT_L(0); PG8_MMA(1, 0, At, B0); PG8_BAR; PG8_SCHED;
            PG8_STAGE(PG8_SB(0, 1), b2 + hstep, voffB);
            PG8_WAIT_V(6); PG8_BAR; PG8_MMA(1, 1, At, B1); PG8_BAR;
            PG8_LDB(B0, 1, 0); PG8_SCHED; PG8_LDA(At, 1, 0); PG8_STAGE(PG8_SA(0, 1), a2 + hstep, voffA);
            PG8_WAIT_L(8); PG8_BAR; PG8_WAIT_L(0); PG8_MMA(0, 0, At, B0); PG8_BAR; PG8_SCHED;
            PG8_LDB(B1, 1, 1); PG8_STAGE(PG8_SB(1, 0), b3, voffB);
            PG8_BAR; PG8_WAIT_L(0); PG8_MMA(0, 1, At, B1); PG8_BAR;
            PG8_LDA(At, 1, 1); PG8_STAGE(PG8_SA(1, 0), a3, voffA);
            PG8_BAR; PG8_WAIT_L(0); PG8_MMA(1, 0, At, B0); PG8_BAR; PG8_SCHED;
            PG8_STAGE(PG8_SB(1, 1), b3 + hstep, voffB);
            PG8_WAIT_V(6); PG8_BAR; PG8_MMA(1, 1, At, B1); PG8_BAR;
            }
        }
        if constexpr (ALIGN_EPI) { if (wr == 0) PG8_BAR; }
        if constexpr (!Epi::AFTER_DRAIN) { E(acc, cur, wr, wc, fr, fq); S.done(cur); }
        if (!has_next) break;
#pragma unroll
        for (int a = 0; a < 2; ++a)
#pragma unroll
            for (int b = 0; b < 2; ++b)
#pragma unroll
                for (int m = 0; m < 4; ++m)
#pragma unroll
                    for (int n = 0; n < 2; ++n) acc[a][b][m][n] = (f32x4){0.f, 0.f, 0.f, 0.f};
        cur = nxt; cA = nA; cB = nB; ++ui;
        if constexpr (ALIGN_EPI) { if (wr == 1) PG8_BAR; }
    }
    PG8_WAIT_V(0);
    if constexpr (!ALIGN_EPI) { if (wr == 0) PG8_BAR; }
    PG8_BAR;
    if constexpr (Epi::AFTER_DRAIN) { E.fused(acc, cur, wr, wc, fr, fq, lds, wid, lane); S.done(cur); }
#undef PG8_SA
#undef PG8_SB
#undef PG8_STAGE
#undef PG8_LDA
#undef PG8_LDB
#undef PG8_MMA
#undef PG8_WAIT_V
#undef PG8_WAIT_L
#undef PG8_BAR
#undef PG8_SCHED
}
}

typedef unsigned short bf16_t;
typedef short bf16x8 __attribute__((ext_vector_type(8)));
typedef float f32x4 __attribute__((ext_vector_type(4)));
typedef unsigned u32x4 __attribute__((ext_vector_type(4)));
typedef unsigned u32x2 __attribute__((ext_vector_type(2)));

constexpr int NB = 4, SEQ = 8192, DM = 1024, MTOK = NB * SEQ, DEPTH = 2;
constexpr int DIN = 3596, NPROJ = 3584, DFF = 2816, NUP = 5632;
constexpr int NTHR = 512;
constexpr float LOG2E = 1.4426950408889634f;
constexpr float QSCALE = 0.125f * LOG2E;
constexpr float EPS = 1e-6f;
constexpr int MHALF = MTOK / 2;

constexpr size_t MiB = 1048576;
constexpr size_t WS_CTRL = 0;
constexpr size_t WS_MOD  = 4096;
constexpr size_t WS_WSC  = WS_MOD + 2 * 4 * 6144 * 4;
constexpr size_t WS_F    = WS_WSC + 2 * 12 * 1024 * 4;
constexpr size_t WS_EGL  = WS_F + 16 * 8192 * 4;
constexpr size_t WS_SCAL = 1 * MiB;
constexpr size_t WS_WTIN = 3 * MiB;
constexpr size_t WS_WTOUT = 17 * MiB;
constexpr size_t WS_WTUP = 21 * MiB;
constexpr size_t WS_WTDN = 43 * MiB;
constexpr size_t WS_HBUF = 54 * MiB;
constexpr size_t WS_R1   = 118 * MiB;
constexpr size_t WS_PAB  = WS_R1;
constexpr size_t WS_PC   = WS_R1 + 96 * MiB;
constexpr size_t WS_PZ   = WS_R1 + 192 * MiB;
constexpr size_t WS_PREP = WS_R1 + 224 * MiB;
constexpr size_t WS_UH   = WS_R1;
constexpr size_t WS_ACT  = WS_R1 + 176 * MiB;
constexpr size_t WS_END  = WS_R1 + 368 * MiB;
constexpr int PREP_UNIT = 73728;
constexpr int LDS_BYTES = 156672;

struct Params {
    const float* in[18];
    float* out;
    unsigned char* ws;
    int ph_lo, ph_hi;
};
enum { I_X = 0, I_C, I_ADAW, I_ADAB, I_NMG, I_NFG, I_WIN, I_WOUT, I_REL, I_FGB, I_CONVW, I_ALOG, I_DTB, I_GNG, I_WUP, I_FCW, I_WDN, I_FNG };

__device__ __forceinline__ float bf2f(unsigned v) { return __uint_as_float(v << 16); }
__device__ __forceinline__ unsigned pack2(float lo, float hi) { return pg8::cvt_pk_bf16(lo, hi); }
__device__ __forceinline__ float wave_sum(float v) {
#pragma unroll
    for (int o = 32; o > 0; o >>= 1) v += __shfl_xor(v, o);
    return v;
}
__device__ __forceinline__ float silu_f(float x) { return x / (1.0f + __expf(-x)); }
__device__ __forceinline__ float softplus_f(float x) { return fmaxf(x, 0.f) + log1pf(__expf(-fabsf(x))); }
__device__ __forceinline__ void unpack8(const u32x4 v, float* f) {
#pragma unroll
    for (int i = 0; i < 4; ++i) { f[2 * i] = __uint_as_float(v[i] << 16); f[2 * i + 1] = __uint_as_float(v[i] & 0xffff0000u); }
}
#define MFMA16(a, b, c) __builtin_amdgcn_mfma_f32_16x16x32_bf16((a), (b), (c), 0, 0, 0)

namespace pg8 {
struct EpiProj {
    static constexpr bool PERM = true, AFTER_DRAIN = false;
    bf16_t* pab; bf16_t* pc; bf16_t* pz;
    __device__ __forceinline__ void operator()(const f32x4 (&acc)[2][2][4][2], const Unit& u, int wr, int wc, int fr, int fq) const {
        bf16_t* base; int ldc, colt; float sc = 1.f;
        if (u.pn < 6) { base = pab; ldc = 1536; colt = u.pn * 256; if (u.pn == 0 || u.pn == 3) sc = QSCALE; }
        else if (u.pn < 12) { base = pc; ldc = 1536; colt = (u.pn - 6) * 256; }
        else { base = pz; ldc = 512; colt = (u.pn - 12) * 256; }
        const int row0 = u.pm * BM + wr * 64 + fr, col0 = colt + wc * 32 + 8 * fq;
#pragma unroll
        for (int ai = 0; ai < 2; ++ai)
#pragma unroll
            for (int m = 0; m < 4; ++m) { bf16_t* rowp = base + (size_t)(row0 + ai * HALF + m * 16) * ldc + col0;
#pragma unroll
                for (int bj = 0; bj < 2; ++bj) { const f32x4 v0 = acc[ai][bj][m][0] * sc, v1 = acc[ai][bj][m][1] * sc;
                    u32x4 w; w.x = cvt_pk_bf16(v0[0], v0[1]); w.y = cvt_pk_bf16(v0[2], v0[3]); w.z = cvt_pk_bf16(v1[0], v1[1]); w.w = cvt_pk_bf16(v1[2], v1[3]);
                    *(u32x4*)(rowp + bj * HALF) = w; } }
    }
};
struct EpiPlain {
    static constexpr bool PERM = true, AFTER_DRAIN = false;
    bf16_t* O; int ldc;
    __device__ __forceinline__ void operator()(const f32x4 (&acc)[2][2][4][2], const Unit& u, int wr, int wc, int fr, int fq) const {
        const int row0 = u.pm * BM + wr * 64 + fr, col0 = u.pn * BM + wc * 32 + 8 * fq;
#pragma unroll
        for (int ai = 0; ai < 2; ++ai)
#pragma unroll
            for (int m = 0; m < 4; ++m) { bf16_t* rowp = O + (size_t)(row0 + ai * HALF + m * 16) * ldc + col0;
#pragma unroll
                for (int bj = 0; bj < 2; ++bj) { const f32x4 v0 = acc[ai][bj][m][0], v1 = acc[ai][bj][m][1];
                    u32x4 w; w.x = cvt_pk_bf16(v0[0], v0[1]); w.y = cvt_pk_bf16(v0[2], v0[3]); w.z = cvt_pk_bf16(v1[0], v1[1]); w.w = cvt_pk_bf16(v1[2], v1[3]);
                    *(u32x4*)(rowp + bj * HALF) = w; } }
    }
};
struct EpiRes {
    static constexpr bool PERM = false, AFTER_DRAIN = false;
    const float* base; float* out; const float* gate; int row_off;
    __device__ __forceinline__ void operator()(const f32x4 (&acc)[2][2][4][2], const Unit& u, int wr, int wc, int fr, int fq) const {
        const int col0 = u.pn * BM + wc * 32 + 4 * fq;
        const int rbase = row_off + u.pm * BM;
        const float* gp = gate + (size_t)(rbase >> 13) * 6144 + col0;
        f32x4 gv[2][2];
#pragma unroll
        for (int bj = 0; bj < 2; ++bj)
#pragma unroll
            for (int n = 0; n < 2; ++n) gv[bj][n] = *(const f32x4*)(gp + bj * HALF + n * 16);
#pragma unroll
        for (int ai = 0; ai < 2; ++ai)
#pragma unroll
            for (int m = 0; m < 4; ++m) { const size_t off = (size_t)(rbase + ai * HALF + wr * 64 + m * 16 + fr) * 1024 + col0;
#pragma unroll
                for (int bj = 0; bj < 2; ++bj)
#pragma unroll
                    for (int n = 0; n < 2; ++n) { const f32x4 bs = *(const f32x4*)(base + off + bj * HALF + n * 16);
                        *(f32x4*)(out + off + bj * HALF + n * 16) = bs + gv[bj][n] * acc[ai][bj][m][n]; } }
    }
};
}

__device__ __forceinline__ void transpose_tile(float* tile  , const float* src, int lds_, int scol0, int k0, bf16_t* dst, int ldd, int drow0) {
    const int tid = my_tid();
#pragma unroll
    for (int i = 0; i < 8; ++i) { const int idx = tid + NTHR * i, kk = idx >> 6, nn = idx & 63; tile[kk * 65 + nn] = src[(size_t)(k0 + kk) * lds_ + scol0 + nn]; }
    __syncthreads();
#pragma unroll
    for (int i = 0; i < 4; ++i) { const int idx = tid + NTHR * i, nn = idx >> 5, kp = idx & 31;
        *(unsigned*)(dst + (size_t)(drow0 + nn) * ldd + k0 + 2 * kp) = pack2(tile[(2 * kp) * 65 + nn], tile[(2 * kp + 1) * 65 + nn]); }
    __syncthreads();
}

__device__ void phase_prologue(const Params& p, unsigned char* lds) {
    const int tid = my_tid();
    float* tile = (float*)lds;
    if (my_bid() == 0 && tid < 64) ((unsigned*)(p.ws + WS_CTRL))[tid] = 0u;
    constexpr int T_IN = 16 * 56, T_OUT = 16 * 16, T_UP = 16 * 88, T_DN = 44 * 16, T_L = T_IN + T_OUT + T_UP + T_DN;
    constexpr int N_T = 2 * T_L, N_MOD = 2 * 96, N_WSC = 24, N_ALL = N_T + N_MOD + N_WSC;
    for (int it = my_bid(); it < N_ALL; it += my_gdim()) {
        if (it < N_T) {
            const int l = it / T_L; int r = it % T_L;
            if (r < T_IN) { const int kt = r / 56, nt = r % 56, d0 = nt * 64; const int s0 = d0 < 1536 ? d0 : (d0 < 3072 ? d0 + 4 : d0 + 12);
                transpose_tile(tile, p.in[I_WIN] + (size_t)l * DM * DIN, DIN, s0, kt * 64, (bf16_t*)(p.ws + WS_WTIN) + (size_t)l * NPROJ * DM, DM, d0); }
            else if ((r -= T_IN) < T_OUT) { const int kt = r / 16, nt = r % 16;
                transpose_tile(tile, p.in[I_WOUT] + (size_t)l * DM * DM, DM, nt * 64, kt * 64, (bf16_t*)(p.ws + WS_WTOUT) + (size_t)l * DM * DM, DM, nt * 64); }
            else if ((r -= T_OUT) < T_UP) { const int kt = r / 88, nt = r % 88;
                transpose_tile(tile, p.in[I_WUP] + (size_t)l * DM * NUP, NUP, nt * 64, kt * 64, (bf16_t*)(p.ws + WS_WTUP) + (size_t)l * NUP * DM, DM, nt * 64); }
            else { r -= T_UP; const int kt = r / 16, nt = r % 16;
                transpose_tile(tile, p.in[I_WDN] + (size_t)l * DFF * DM, DM, nt * 64, kt * 64, (bf16_t*)(p.ws + WS_WTDN) + (size_t)l * DM * DFF, DFF, nt * 64); }
        } else if (it < N_T + N_MOD) {
            const int r = it - N_T, l = r / 96, n0 = (r % 96) * 64, kg = tid >> 6, col = tid & 63;
            const float* aw = p.in[I_ADAW] + (size_t)l * DM * 6144 + n0 + col; const float* cc = p.in[I_C];
            float a0 = 0.f, a1 = 0.f, a2 = 0.f, a3 = 0.f;
            for (int k = kg; k < DM; k += 8) { const float w = aw[(size_t)k * 6144];
                a0 += silu_f(cc[k]) * w; a1 += silu_f(cc[DM + k]) * w; a2 += silu_f(cc[2 * DM + k]) * w; a3 += silu_f(cc[3 * DM + k]) * w; }
            float* red = tile;
            red[(kg * 4 + 0) * 64 + col] = a0; red[(kg * 4 + 1) * 64 + col] = a1; red[(kg * 4 + 2) * 64 + col] = a2; red[(kg * 4 + 3) * 64 + col] = a3;
            __syncthreads();
            if (tid < 256) { const int b = tid >> 6; float s = 0.f;
#pragma unroll
                for (int g = 0; g < 8; ++g) s += red[(g * 4 + b) * 64 + col];
                ((float*)(p.ws + WS_MOD))[((size_t)l * 4 + b) * 6144 + n0 + col] = s + p.in[I_ADAB][(size_t)l * 6144 + n0 + col]; }
            __syncthreads();
        } else {
            const int r = it - N_T - N_MOD, l = r / 12, j = r % 12; const int sc = j < 4 ? 1536 + j : (j < 8 ? 3076 + (j - 4) : 3080 + (j - 8));
            float* dst = (float*)(p.ws + WS_WSC) + ((size_t)l * 12 + j) * DM; const float* src = p.in[I_WIN] + (size_t)l * DM * DIN + sc;
            for (int k = tid; k < DM; k += NTHR) dst[k] = src[(size_t)k * DIN];
        }
    }
}

__device__ void phase_norm(const Params& p, unsigned char* lds, const float* xin, const float* g, const float* mod  , int shift_off, int scale_off, bf16_t* hout, const float* wsc  , float* scal) {
    const int tid = my_tid(), wid = tid >> 6, lane = tid & 63;
    float* wl = (float*)lds;
    if (wsc) { for (int i = tid; i < 12 * DM; i += NTHR) wl[i] = wsc[i]; __syncthreads(); }
    const int gw = my_bid() * 8 + wid, nw = my_gdim() * 8;
    for (int rb = gw * 16; rb < MTOK; rb += nw * 16) {
        const int b = rb >> 13;
        float cs[16], sh[16];
#pragma unroll
        for (int i = 0; i < 2; ++i)
#pragma unroll
            for (int j = 0; j < 8; ++j) { const int k = i * 512 + lane * 8 + j; cs[i * 8 + j] = g[k] * (1.0f + mod[(size_t)b * 6144 + scale_off + k]); sh[i * 8 + j] = mod[(size_t)b * 6144 + shift_off + k]; }
        for (int r = 0; r < 16; ++r) {
            const int row = rb + r; const float* xp = xin + (size_t)row * DM + lane * 8;
            const f32x4 x0 = *(const f32x4*)xp, x1 = *(const f32x4*)(xp + 4), x2 = *(const f32x4*)(xp + 512), x3 = *(const f32x4*)(xp + 516);
            float xv[16] = {x0[0], x0[1], x0[2], x0[3], x1[0], x1[1], x1[2], x1[3], x2[0], x2[1], x2[2], x2[3], x3[0], x3[1], x3[2], x3[3]};
            float ss = 0.f;
#pragma unroll
            for (int i = 0; i < 16; ++i) ss += xv[i] * xv[i];
            ss = wave_sum(ss);
            const float rstd = rsqrtf(ss * (1.0f / DM) + EPS);
            float h[16];
#pragma unroll
            for (int i = 0; i < 16; ++i) h[i] = xv[i] * rstd * cs[i] + sh[i];
            u32x4 w0, w1;
            w0.x = pack2(h[0], h[1]); w0.y = pack2(h[2], h[3]); w0.z = pack2(h[4], h[5]); w0.w = pack2(h[6], h[7]);
            w1.x = pack2(h[8], h[9]); w1.y = pack2(h[10], h[11]); w1.z = pack2(h[12], h[13]); w1.w = pack2(h[14], h[15]);
            bf16_t* hp = hout + (size_t)row * DM + lane * 8;
            *(u32x4*)hp = w0; *(u32x4*)(hp + 512) = w1;
            if (wsc) {
#pragma unroll
                for (int j = 0; j < 12; ++j) {
                    const float* wj = wl + j * DM + lane * 8;
                    const f32x4 a0 = *(const f32x4*)wj, a1 = *(const f32x4*)(wj + 4), a2 = *(const f32x4*)(wj + 512), a3 = *(const f32x4*)(wj + 516);
                    float s = h[0] * a0[0] + h[1] * a0[1] + h[2] * a0[2] + h[3] * a0[3] + h[4] * a1[0] + h[5] * a1[1] + h[6] * a1[2] + h[7] * a1[3]
                            + h[8] * a2[0] + h[9] * a2[1] + h[10] * a2[2] + h[11] * a2[3] + h[12] * a3[0] + h[13] * a3[1] + h[14] * a3[2] + h[15] * a3[3];
                    s = wave_sum(s);
                    if (lane == j) scal[(size_t)row * 16 + j] = s;
                }
            }
        }
    }
}

__device__ void phase_final_norm(const float* xin, const float* g, float* out) {
    const int tid = my_tid(), wid = tid >> 6, lane = tid & 63;
    const int gw = my_bid() * 8 + wid, nw = my_gdim() * 8;
    f32x4 gv[4];
#pragma unroll
    for (int i = 0; i < 4; ++i) gv[i] = *(const f32x4*)(g + i * 256 + lane * 4);
    for (int row = gw; row < MTOK; row += nw) {
        f32x4 x[4]; float ss = 0.f;
#pragma unroll
        for (int i = 0; i < 4; ++i) { x[i] = *(const f32x4*)(xin + (size_t)row * DM + i * 256 + lane * 4); ss += x[i][0] * x[i][0] + x[i][1] * x[i][1] + x[i][2] * x[i][2] + x[i][3] * x[i][3]; }
        ss = wave_sum(ss);
        const float rstd = rsqrtf(ss * (1.0f / DM) + EPS);
#pragma unroll
        for (int i = 0; i < 4; ++i) *(f32x4*)(out + (size_t)row * DM + i * 256 + lane * 4) = x[i] * rstd * gv[i];
    }
}

__device__ void phase_finalize(const float* oc, const bf16_t* pz, const float* gn, bf16_t* mix) {
    const int tid = my_tid(), wid = tid >> 6, lane = tid & 63;
    const int gw = my_bid() * 8 + wid, nw = my_gdim() * 8;
    const int d0 = (lane & 15) * 8;
    float gv[8];
#pragma unroll
    for (int j = 0; j < 8; ++j) gv[j] = gn[d0 + j];
    for (int row = gw; row < MTOK; row += nw) {
        const float* op = oc + (size_t)row * 512 + lane * 8;
        const f32x4 o0 = *(const f32x4*)op, o1 = *(const f32x4*)(op + 4);
        float ov[8] = {o0[0], o0[1], o0[2], o0[3], o1[0], o1[1], o1[2], o1[3]};
        float ss = 0.f;
#pragma unroll
        for (int j = 0; j < 8; ++j) ss += ov[j] * ov[j];
        ss += __shfl_xor(ss, 1); ss += __shfl_xor(ss, 2); ss += __shfl_xor(ss, 4); ss += __shfl_xor(ss, 8);
        const float rstd = rsqrtf(ss * (1.0f / 128.0f) + EPS);
        const u32x4 zz = *(const u32x4*)(pz + (size_t)row * 512 + lane * 8);
        float zf[8]; unpack8(zz, zf);
        float r[8];
#pragma unroll
        for (int j = 0; j < 8; ++j) r[j] = ov[j] * rstd * gv[j] * silu_f(zf[j]);
        u32x4 w; w.x = pack2(r[0], r[1]); w.y = pack2(r[2], r[3]); w.z = pack2(r[4], r[5]); w.w = pack2(r[6], r[7]);
        *(u32x4*)(mix + (size_t)row * DM + 512 + lane * 8) = w;
    }
}

__device__ void phase_act(const bf16_t* uh, const float* cw  , bf16_t* act) {
    const int gt = my_bid() * NTHR + my_tid(), stride = my_gdim() * NTHR;
    constexpr int NCG = DFF / 8, NRUN = MHALF / 16;
    for (int task = gt; task < NCG * NRUN; task += stride) {
        const int cgp = task % NCG, run = task / NCG, c0 = cgp * 8, r0 = run * 16;
        float wg[3][8], wu[3][8];
#pragma unroll
        for (int i = 0; i < 3; ++i)
#pragma unroll
            for (int j = 0; j < 8; ++j) { wg[i][j] = cw[i * NUP + c0 + j]; wu[i][j] = cw[i * NUP + DFF + c0 + j]; }
        float g2[8], g1[8], u2[8], u1[8];
        if ((r0 & (SEQ - 1)) == 0) {
#pragma unroll
            for (int j = 0; j < 8; ++j) { g2[j] = 0.f; g1[j] = 0.f; u2[j] = 0.f; u1[j] = 0.f; }
        } else {
            unpack8(*(const u32x4*)(uh + (size_t)(r0 - 2) * NUP + c0), g2); unpack8(*(const u32x4*)(uh + (size_t)(r0 - 1) * NUP + c0), g1);
            unpack8(*(const u32x4*)(uh + (size_t)(r0 - 2) * NUP + DFF + c0), u2); unpack8(*(const u32x4*)(uh + (size_t)(r0 - 1) * NUP + DFF + c0), u1);
        }
#pragma unroll 4
        for (int r = 0; r < 16; ++r) {
            float g0[8], u0[8];
            unpack8(*(const u32x4*)(uh + (size_t)(r0 + r) * NUP + c0), g0); unpack8(*(const u32x4*)(uh + (size_t)(r0 + r) * NUP + DFF + c0), u0);
            float o[8];
#pragma unroll
            for (int j = 0; j < 8; ++j) { const float gc = wg[0][j] * g2[j] + wg[1][j] * g1[j] + wg[2][j] * g0[j], uc = wu[0][j] * u2[j] + wu[1][j] * u1[j] + wu[2][j] * u0[j];
                o[j] = silu_f(gc) * uc; g2[j] = g1[j]; g1[j] = g0[j]; u2[j] = u1[j]; u1[j] = u0[j]; }
            u32x4 w; w.x = pack2(o[0], o[1]); w.y = pack2(o[2], o[3]); w.z = pack2(o[4], o[5]); w.w = pack2(o[6], o[7]);
            *(u32x4*)(act + (size_t)(r0 + r) * DFF + c0) = w;
        }
    }
}

__device__ void fcum_unit(unsigned char* lds, int bh, const float* scal, const float* fgb  , float* F) {
    const int tid = my_tid(), wid = tid >> 6, lane = tid & 63, b = bh >> 2, h = bh & 3;
    float* wt = (float*)lds;
    const float fb = fgb[h];
    float v[16]; float run = 0.f;
#pragma unroll
    for (int i = 0; i < 16; ++i) { const float x = scal[((size_t)b * SEQ + tid * 16 + i) * 16 + h] + fb; run += fminf(x, 0.f) - log1pf(__expf(-fabsf(x))); v[i] = run; }
    float inc = run;
#pragma unroll
    for (int o = 1; o < 64; o <<= 1) { const float y = __shfl_up(inc, o); if (lane >= o) inc += y; }
    if (lane == 63) wt[wid] = inc;
    __syncthreads();
    float off = inc - run;
    for (int w = 0; w < wid; ++w) off += wt[w];
#pragma unroll
    for (int i = 0; i < 16; ++i) F[(size_t)bh * SEQ + tid * 16 + i] = v[i] + off;
    __syncthreads();
}

__device__ void prep_unit(unsigned char* lds, int bh, int n, const bf16_t* pc, const float* scal, const float* convw  , float alog, float dtb, unsigned char* unit, float* egl) {
    const int tid = my_tid(), wid = tid >> 6, lane = tid & 63, b = bh >> 2, h = bh & 3;
    float* qT = (float*)lds; float* kT = (float*)(lds + 34816); float* vT = (float*)(lds + 69632);
    float* Am = (float*)(lds + 104448); float* At = (float*)(lds + 121856);
    float* gc = (float*)(lds + 139264); float* bet = gc + 64; float* rq = gc + 128; float* rk = gc + 192;
    bf16_t* stage = (bf16_t*)(lds + 140288);
    const size_t row0 = (size_t)b * SEQ + (size_t)n * 64;
    if (tid < 384) {
        const int part = tid >> 7, cg8 = (tid & 127) >> 3, run = tid & 7, col = part * 512 + h * 128 + cg8 * 8;
        float w[4][8];
#pragma unroll
        for (int i = 0; i < 4; ++i)
#pragma unroll
            for (int j = 0; j < 8; ++j) w[i][j] = convw[i * 1536 + col + j];
        u32x4 xr[11];
#pragma unroll
        for (int i = 0; i < 11; ++i) { const int tl = run * 8 - 3 + i; const bool ok = (n > 0) || (tl >= 0);
            xr[i] = ok ? *(const u32x4*)(pc + (row0 + tl) * 1536 + col) : (u32x4){0u, 0u, 0u, 0u}; }
        float y[8][8];
#pragma unroll
        for (int t = 0; t < 8; ++t)
#pragma unroll
            for (int j = 0; j < 8; ++j) y[t][j] = 0.f;
#pragma unroll
        for (int i = 0; i < 11; ++i) { float xf[8]; unpack8(xr[i], xf);
#pragma unroll
            for (int t = 0; t < 8; ++t) { const int wi = i - t; if (wi >= 0 && wi < 4) {
#pragma unroll
                for (int j = 0; j < 8; ++j) y[t][j] += w[wi][j] * xf[j]; } } }
        float* XT = part == 0 ? qT : (part == 1 ? kT : vT);
#pragma unroll
        for (int j = 0; j < 8; ++j) {
            f32x4 a, c;
            a[0] = silu_f(y[0][j]); a[1] = silu_f(y[1][j]); a[2] = silu_f(y[2][j]); a[3] = silu_f(y[3][j]);
            c[0] = silu_f(y[4][j]); c[1] = silu_f(y[5][j]); c[2] = silu_f(y[6][j]); c[3] = silu_f(y[7][j]);
            *(f32x4*)(XT + (cg8 * 8 + j) * 68 + run * 8) = a; *(f32x4*)(XT + (cg8 * 8 + j) * 68 + run * 8 + 4) = c;
        }
    } else if (tid < 448) {
        const int t = tid - 384; const float* sp = scal + (row0 + t) * 16;
        bet[t] = 1.0f / (1.0f + __expf(-sp[4 + h]));
        gc[t] = -__expf(alog) * softplus_f(sp[8 + h] + dtb);
    }
    __syncthreads();
    if (tid < 64) { float s = 0.f; for (int d = 0; d < 128; ++d) { const float x = qT[d * 68 + tid]; s += x * x; } rq[tid] = rsqrtf(s + EPS) * 0.08838834764831845f; }
    else if (tid < 128) { const int t = tid - 64; float s = 0.f; for (int d = 0; d < 128; ++d) { const float x = kT[d * 68 + t]; s += x * x; } rk[t] = rsqrtf(s + EPS); }
    else if (tid < 192) { float v = gc[lane];
#pragma unroll
        for (int o = 1; o < 64; o <<= 1) { const float y = __shfl_up(v, o); if (lane >= o) v += y; }
        gc[lane] = v; }
    __syncthreads();
    for (int idx = tid; idx < 8192; idx += NTHR) { const int d = idx >> 6, t = idx & 63; qT[d * 68 + t] *= rq[t]; kT[d * 68 + t] *= rk[t]; }
    __syncthreads();
    {
        const int u = tid & 255, ti = u >> 4, tj = u & 15; const bool isq = tid >= 256;
        const float* XT = isq ? qT : kT;
        float acc[4][4];
#pragma unroll
        for (int x = 0; x < 4; ++x)
#pragma unroll
            for (int y = 0; y < 4; ++y) acc[x][y] = 0.f;
        for (int d = 0; d < 128; ++d) {
            const f32x4 a = *(const f32x4*)(XT + d * 68 + 4 * ti), bb = *(const f32x4*)(kT + d * 68 + 4 * tj);
#pragma unroll
            for (int x = 0; x < 4; ++x)
#pragma unroll
                for (int y = 0; y < 4; ++y) acc[x][y] += a[x] * bb[y];
        }
        float* Out = isq ? At : Am;
#pragma unroll
        for (int x = 0; x < 4; ++x) { const int i = 4 * ti + x; f32x4 o;
#pragma unroll
            for (int y = 0; y < 4; ++y) { const int j = 4 * tj + y; const float e = __expf(fminf(gc[i] - gc[j], 0.f));
                const bool keep = isq ? (i >= j) : (i > j); const float v = acc[x][y] * e * (isq ? 1.0f : bet[i]); o[y] = keep ? v : 0.f; }
            *(f32x4*)(Out + i * 68 + 4 * tj) = o; }
    }
    __syncthreads();
    if (tid < 256) {
        const int c = tid; const float* src = c < 128 ? vT + c * 68 : kT + (c - 128) * 68;
        float X[64];
#pragma unroll
        for (int i4 = 0; i4 < 16; ++i4) { const f32x4 r = *(const f32x4*)(src + 4 * i4);
#pragma unroll
            for (int j = 0; j < 4; ++j) { const int i = 4 * i4 + j; X[i] = r[j] * bet[i] * (c < 128 ? 1.0f : __expf(gc[i])); } }
        int zv = 0; asm volatile("" : "+v"(zv)); const float* AmV = Am + zv;
#pragma unroll
        for (int i = 1; i < 64; ++i) { float s = X[i];
#pragma unroll
            for (int j4 = 0; j4 < (i + 3) / 4; ++j4) { const f32x4 a = *(const f32x4*)(AmV + i * 68 + 4 * j4);
#pragma unroll
                for (int j = 0; j < 4; ++j) if (4 * j4 + j < i) s -= a[j] * X[4 * j4 + j]; }
            X[i] = s; }
        if (c < 128) { bf16_t* ut = (bf16_t*)(unit + 57344) + c * 64;
#pragma unroll
            for (int q = 0; q < 8; ++q) { u32x4 w; w.x = pack2(X[8 * q], X[8 * q + 1]); w.y = pack2(X[8 * q + 2], X[8 * q + 3]); w.z = pack2(X[8 * q + 4], X[8 * q + 5]); w.w = pack2(X[8 * q + 6], X[8 * q + 7]);
                *(u32x4*)(ut + 8 * q) = w; } }
        else { const int kd = c - 128, ks = kd >> 5, kd32 = kd & 31, hh = kd32 >> 4, quad = (kd32 >> 2) & 3, j = kd32 & 3;
#pragma unroll
            for (int i = 0; i < 64; i += 2) { const unsigned pk = pack2(-X[i], -X[i + 1]);
                stage[((i >> 4) * 4 + ks) * 512 + (quad * 16 + (i & 15)) * 8 + hh * 4 + j] = (bf16_t)(pk & 0xffffu);
                stage[(((i + 1) >> 4) * 4 + ks) * 512 + (quad * 16 + ((i + 1) & 15)) * 8 + hh * 4 + j] = (bf16_t)(pk >> 16); } }
    } else {
        const int u = tid - 256; const float glast = gc[63];
#pragma unroll
        for (int it = 0; it < 4; ++it) {
            const int q = u + 256 * it, f = q >> 6, L = q & 63, mt = f >> 2, ks = f & 3, quad = L >> 4, r = L & 15, i_ = 16 * mt + r;
            const float eg = __expf(gc[i_]); float v[8];
#pragma unroll
            for (int jj = 0; jj < 8; ++jj) { const int kd = 32 * ks + 16 * (jj >> 2) + 4 * quad + (jj & 3); v[jj] = qT[kd * 68 + i_] * eg; }
            u32x4 w; w.x = pack2(v[0], v[1]); w.y = pack2(v[2], v[3]); w.z = pack2(v[4], v[5]); w.w = pack2(v[6], v[7]);
            *(u32x4*)(unit + 16384 + q * 16) = w;
        }
#pragma unroll
        for (int it = 0; it < 4; ++it) {
            const int q = u + 256 * it, f = q >> 6, L = q & 63, mt = f >> 1, ks = f & 1, quad = L >> 4, r = L & 15, kd = 16 * mt + r;
            float v[8];
#pragma unroll
            for (int hh = 0; hh < 2; ++hh) { const int c0 = 32 * ks + 16 * hh + 4 * quad; const f32x4 kk = *(const f32x4*)(kT + kd * 68 + c0), gg = *(const f32x4*)(gc + c0);
#pragma unroll
                for (int j = 0; j < 4; ++j) v[hh * 4 + j] = kk[j] * __expf(glast - gg[j]); }
            u32x4 w; w.x = pack2(v[0], v[1]); w.y = pack2(v[2], v[3]); w.z = pack2(v[4], v[5]); w.w = pack2(v[6], v[7]);
            *(u32x4*)(unit + 32768 + q * 16) = w;
        }
#pragma unroll
        for (int it = 0; it < 2; ++it) {
            const int q = u + 256 * it, f = q >> 6, L = q & 63, mt = f >> 1, ks = f & 1, quad = L >> 4, r = L & 15, i_ = 16 * mt + r;
            const f32x4 a0 = *(const f32x4*)(At + i_ * 68 + 32 * ks + 4 * quad), a1 = *(const f32x4*)(At + i_ * 68 + 32 * ks + 16 + 4 * quad);
            u32x4 w; w.x = pack2(a0[0], a0[1]); w.y = pack2(a0[2], a0[3]); w.z = pack2(a1[0], a1[1]); w.w = pack2(a1[2], a1[3]);
            *(u32x4*)(unit + 49152 + q * 16) = w;
        }
        if (u == 0) egl[bh * 128 + n] = __expf(glast);
    }
    __syncthreads();
#pragma unroll
    for (int it = 0; it < 2; ++it) { const int q = tid + NTHR * it; *(u32x4*)(unit + q * 16) = *(const u32x4*)((const unsigned char*)stage + q * 16); }
    __syncthreads();
}

__device__ void scan_unit(unsigned char* lds, int bh, int half, const unsigned char* prep, const float* egl, float* oc) {
    const int tid = my_tid(), wid = tid >> 6, lane = tid & 63, b = bh >> 2, h = bh & 3, quad = lane >> 4, cl = lane & 15;
    const unsigned char* ubase = prep + (size_t)bh * 128 * PREP_UNIT;
    const int col0 = half * 64 + wid * 16;
    f32x4 Sacc[8]; bf16x8 Sb[4];
#pragma unroll
    for (int i = 0; i < 8; ++i) Sacc[i] = (f32x4){0.f, 0.f, 0.f, 0.f};
#pragma unroll
    for (int i = 0; i < 4; ++i) Sb[i] = (bf16x8){0, 0, 0, 0, 0, 0, 0, 0};
    u32x4 rg[7];
#pragma unroll
    for (int i = 0; i < 7; ++i) rg[i] = *(const u32x4*)(ubase + (size_t)(tid + NTHR * i) * 16);
#pragma unroll
    for (int i = 0; i < 7; ++i) *(u32x4*)(lds + (size_t)(tid + NTHR * i) * 16) = rg[i];
    __syncthreads();
    for (int n = 0; n < 128; ++n) {
        const unsigned char* un = ubase + (size_t)n * PREP_UNIT;
        if (n + 1 < 128) {
#pragma unroll
            for (int i = 0; i < 7; ++i) rg[i] = *(const u32x4*)(un + PREP_UNIT + (size_t)(tid + NTHR * i) * 16);
        }
        if (wid < 4) {
            const unsigned char* B = lds + (n & 1) * 57344;
            const float eg = egl[bh * 128 + n];
            f32x4 vn[4];
#pragma unroll
            for (int mt = 0; mt < 4; ++mt) {
                const u32x2 ut = *(const u32x2*)(un + 57344 + ((size_t)(col0 + cl) * 64 + 16 * mt + quad * 4) * 2);
                f32x4 acc; acc[0] = __uint_as_float(ut.x << 16); acc[1] = __uint_as_float(ut.x & 0xffff0000u); acc[2] = __uint_as_float(ut.y << 16); acc[3] = __uint_as_float(ut.y & 0xffff0000u);
#pragma unroll
                for (int ks = 0; ks < 4; ++ks) acc = MFMA16(*(const bf16x8*)(B + (mt * 4 + ks) * 1024 + lane * 16), Sb[ks], acc);
                vn[mt] = acc;
            }
            bf16x8 Vb[2];
#pragma unroll
            for (int ks = 0; ks < 2; ++ks) { u32x4 w; w.x = pack2(vn[2 * ks][0], vn[2 * ks][1]); w.y = pack2(vn[2 * ks][2], vn[2 * ks][3]); w.z = pack2(vn[2 * ks + 1][0], vn[2 * ks + 1][1]); w.w = pack2(vn[2 * ks + 1][2], vn[2 * ks + 1][3]);
                Vb[ks] = __builtin_bit_cast(bf16x8, w); }
#pragma unroll
            for (int mt = 0; mt < 4; ++mt) {
                f32x4 acc = (f32x4){0.f, 0.f, 0.f, 0.f};
#pragma unroll
                for (int ks = 0; ks < 4; ++ks) acc = MFMA16(*(const bf16x8*)(B + 16384 + (mt * 4 + ks) * 1024 + lane * 16), Sb[ks], acc);
#pragma unroll
                for (int ks = 0; ks < 2; ++ks) acc = MFMA16(*(const bf16x8*)(B + 49152 + (mt * 2 + ks) * 1024 + lane * 16), Vb[ks], acc);
                float* op = oc + ((size_t)b * SEQ + (size_t)n * 64 + 16 * mt + quad * 4) * 512 + h * 128 + col0 + cl;
#pragma unroll
                for (int j = 0; j < 4; ++j) op[(size_t)j * 512] = acc[j];
            }
#pragma unroll
            for (int m8 = 0; m8 < 8; ++m8) {
                f32x4 acc = Sacc[m8] * eg;
#pragma unroll
                for (int ks = 0; ks < 2; ++ks) acc = MFMA16(*(const bf16x8*)(B + 32768 + (m8 * 2 + ks) * 1024 + lane * 16), Vb[ks], acc);
                Sacc[m8] = acc;
            }
#pragma unroll
            for (int ks = 0; ks < 4; ++ks) { u32x4 w; w.x = pack2(Sacc[2 * ks][0], Sacc[2 * ks][1]); w.y = pack2(Sacc[2 * ks][2], Sacc[2 * ks][3]); w.z = pack2(Sacc[2 * ks + 1][0], Sacc[2 * ks + 1][1]); w.w = pack2(Sacc[2 * ks + 1][2], Sacc[2 * ks + 1][3]);
                Sb[ks] = __builtin_bit_cast(bf16x8, w); }
        }
        if (n + 1 < 128) {
#pragma unroll
            for (int i = 0; i < 7; ++i) *(u32x4*)(lds + ((n + 1) & 1) * 57344 + (size_t)(tid + NTHR * i) * 16) = rg[i];
        }
        __syncthreads();
    }
}

template <int MODE>
__device__ void attn_unit(unsigned char* lds, int b, int qb, const bf16_t* Qp, const bf16_t* Kp, const bf16_t* Vp, int ld, bf16_t* Op, int ldo, const float* Fbh, const float* reltab) {
    const int tid = my_tid(), wid = tid >> 6, lane = tid & 63, quad = lane >> 4, cl = lane & 15;
    const size_t rowbase = (size_t)b * SEQ; const int q0 = qb * 256, qw0 = q0 + 32 * wid, cq = qw0 >> 6;
    float* fkb = (float*)(lds + 36864); float* ext = (float*)(lds + 37376);
    const int kt0 = MODE == 0 ? 0 : (q0 / 64 - 8 > 0 ? q0 / 64 - 8 : 0), kt1 = q0 / 64 + 3;
    const float Fref = MODE == 0 ? Fbh[q0] : 0.f;
    if (MODE == 1) { for (int i = tid; i < 640; i += NTHR) { int rel = 575 - i; rel = rel < -63 ? -63 : (rel > 256 ? 256 : rel); ext[i] = reltab[rel + 63] * LOG2E; } }
    bf16x8 qf[2][2];
#pragma unroll
    for (int nq = 0; nq < 2; ++nq)
#pragma unroll
        for (int ks = 0; ks < 2; ++ks) qf[nq][ks] = *(const bf16x8*)(Qp + (rowbase + qw0 + 16 * nq + cl) * ld + 32 * ks + quad * 8);
    float mrun[2] = {-1e30f, -1e30f}, lrun[2] = {0.f, 0.f};
    f32x4 o[4][2];
#pragma unroll
    for (int dt = 0; dt < 4; ++dt)
#pragma unroll
        for (int nq = 0; nq < 2; ++nq) o[dt][nq] = (f32x4){0.f, 0.f, 0.f, 0.f};
    const int skey = tid >> 3, sdch = tid & 7;
    const int spos = (skey & 32) + ((skey >> 2) & 3) * 8 + ((skey >> 4) & 1) * 4 + (skey & 3);
    u32x4 rk, rv; float rf = 0.f;
    rk = *(const u32x4*)(Kp + (rowbase + (size_t)kt0 * 64 + skey) * ld + sdch * 8); rv = *(const u32x4*)(Vp + (rowbase + (size_t)kt0 * 64 + skey) * ld + sdch * 8);
    if (MODE == 0 && tid < 64) rf = Fbh[kt0 * 64 + tid];
    {
        *(u32x4*)(lds + skey * 144 + sdch * 16) = rk;
        bf16_t* vt = (bf16_t*)(lds + 18432);
#pragma unroll
        for (int i = 0; i < 8; ++i) vt[(sdch * 8 + i) * 72 + spos] = (bf16_t)((rv[i >> 1] >> (16 * (i & 1))) & 0xffffu);
        if (MODE == 0 && tid < 64) fkb[tid] = (Fref - rf) * LOG2E;
    }
    __syncthreads();
    for (int kt = kt0; kt <= kt1; ++kt) {
        const int buf = (kt - kt0) & 1;
        if (kt < kt1) {
            rk = *(const u32x4*)(Kp + (rowbase + (size_t)(kt + 1) * 64 + skey) * ld + sdch * 8); rv = *(const u32x4*)(Vp + (rowbase + (size_t)(kt + 1) * 64 + skey) * ld + sdch * 8);
            if (MODE == 0 && tid < 64) rf = Fbh[(kt + 1) * 64 + tid];
        }
        const bool active = MODE == 0 ? (64 * kt <= qw0 + 31) : (kt >= cq - 8 && kt <= cq);
        if (active) {
            const unsigned char* Kb = lds + buf * 9216; const unsigned char* Vb = lds + 18432 + buf * 9216;
            f32x4 s[2][4];
#pragma unroll
            for (int mt = 0; mt < 4; ++mt) {
                const bf16x8 k0 = *(const bf16x8*)(Kb + (16 * mt + cl) * 144 + quad * 16), k1 = *(const bf16x8*)(Kb + (16 * mt + cl) * 144 + 64 + quad * 16);
#pragma unroll
                for (int nq = 0; nq < 2; ++nq) {
                    f32x4 c;
                    if (MODE == 0) c = *(const f32x4*)(fkb + buf * 64 + 16 * mt + quad * 4);
                    else { const int qi = (qw0 + 16 * nq + cl) & 63, idx0 = (kt - (cq - 8)) * 64 + 16 * mt + quad * 4 + 63 - qi; c[0] = ext[idx0]; c[1] = ext[idx0 + 1]; c[2] = ext[idx0 + 2]; c[3] = ext[idx0 + 3]; }
                    c = MFMA16(k0, qf[nq][0], c); c = MFMA16(k1, qf[nq][1], c);
                    s[nq][mt] = c;
                }
            }
            if (MODE == 0 && (64 * kt + 63 > qw0)) {
#pragma unroll
                for (int nq = 0; nq < 2; ++nq) { const int qrow = qw0 + 16 * nq + cl;
#pragma unroll
                    for (int mt = 0; mt < 4; ++mt)
#pragma unroll
                        for (int j = 0; j < 4; ++j) if (64 * kt + 16 * mt + quad * 4 + j > qrow) s[nq][mt][j] = -1e30f; }
            }
            bf16x8 pf[2][2];
#pragma unroll
            for (int nq = 0; nq < 2; ++nq) {
                float mx = s[nq][0][0];
#pragma unroll
                for (int mt = 0; mt < 4; ++mt)
#pragma unroll
                    for (int j = 0; j < 4; ++j) mx = fmaxf(mx, s[nq][mt][j]);
                mx = fmaxf(mx, __shfl_xor(mx, 16)); mx = fmaxf(mx, __shfl_xor(mx, 32));
                const float mnew = fmaxf(mrun[nq], mx), alpha = exp2f(mrun[nq] - mnew);
                mrun[nq] = mnew;
                float ps = 0.f;
#pragma unroll
                for (int mt = 0; mt < 4; ++mt)
#pragma unroll
                    for (int j = 0; j < 4; ++j) { const float pv = exp2f(s[nq][mt][j] - mnew); s[nq][mt][j] = pv; ps += pv; }
                lrun[nq] = lrun[nq] * alpha + ps;
#pragma unroll
                for (int dt = 0; dt < 4; ++dt) o[dt][nq] = o[dt][nq] * alpha;
#pragma unroll
                for (int ks = 0; ks < 2; ++ks) { u32x4 w; w.x = pack2(s[nq][2 * ks][0], s[nq][2 * ks][1]); w.y = pack2(s[nq][2 * ks][2], s[nq][2 * ks][3]); w.z = pack2(s[nq][2 * ks + 1][0], s[nq][2 * ks + 1][1]); w.w = pack2(s[nq][2 * ks + 1][2], s[nq][2 * ks + 1][3]);
                    pf[nq][ks] = __builtin_bit_cast(bf16x8, w); }
            }
#pragma unroll
            for (int dt = 0; dt < 4; ++dt)
#pragma unroll
                for (int ks = 0; ks < 2; ++ks) { const bf16x8 vf = *(const bf16x8*)(Vb + (16 * dt + cl) * 144 + ks * 64 + quad * 16);
                    o[dt][0] = MFMA16(vf, pf[0][ks], o[dt][0]); o[dt][1] = MFMA16(vf, pf[1][ks], o[dt][1]); }
        }
        if (kt < kt1) {
            const int nb = buf ^ 1;
            *(u32x4*)(lds + nb * 9216 + skey * 144 + sdch * 16) = rk;
            bf16_t* vt = (bf16_t*)(lds + 18432 + nb * 9216);
#pragma unroll
            for (int i = 0; i < 8; ++i) vt[(sdch * 8 + i) * 72 + spos] = (bf16_t)((rv[i >> 1] >> (16 * (i & 1))) & 0xffffu);
            if (MODE == 0 && tid < 64) fkb[nb * 64 + tid] = (Fref - rf) * LOG2E;
        }
        __syncthreads();
    }
#pragma unroll
    for (int nq = 0; nq < 2; ++nq) {
        float l = lrun[nq]; l += __shfl_xor(l, 16); l += __shfl_xor(l, 32);
        const float inv = 1.0f / l;
        bf16_t* op = Op + (rowbase + qw0 + 16 * nq + cl) * ldo + quad * 4;
#pragma unroll
        for (int dt = 0; dt < 4; ++dt) { u32x2 w; w.x = pack2(o[dt][nq][0] * inv, o[dt][nq][1] * inv); w.y = pack2(o[dt][nq][2] * inv, o[dt][nq][3] * inv); *(u32x2*)(op + 16 * dt) = w; }
    }
}

constexpr int LDS_SLOT = 156672, LDS_TOTAL = 156688;
constexpr int PH_PER_LAYER = 13, N_PHASES = 1 + DEPTH * PH_PER_LAYER + 1;

__device__ __forceinline__ int fetch_item(unsigned* ctr, unsigned char* lds) {
    volatile int* slot = (volatile int*)(lds + LDS_SLOT);
    __syncthreads();
    if (my_tid() == 0) *slot = (int)atomicAdd(ctr, 1u);
    __syncthreads();
    return *slot;
}

template <class Epi>
__device__ __forceinline__ void run_gemm(unsigned char* lds, const bf16_t* A, const bf16_t* Bt, int M, int N, int K, const Epi& E) {
    pg8::Gemm g{A, Bt, M, N, K}; pg8::StaticOrder S; S.init(M, N, my_gdim(), my_bid());
    pg8::gemm_phase<Epi, pg8::StaticOrder, true, true>((PG8_LAS unsigned char*)lds, g, S, E);
    __syncthreads();
}

__device__ void run_phase(const Params& p, unsigned char* lds, int ph) {
    unsigned char* ws = p.ws;
    float* xs = p.out;
    float* modp = (float*)(ws + WS_MOD);
    bf16_t* hbuf = (bf16_t*)(ws + WS_HBUF);
    if (ph == 0) { phase_prologue(p, lds); return; }
    if (ph == N_PHASES - 1) { phase_final_norm(xs, p.in[I_FNG], p.out); return; }
    const int l = (ph - 1) / PH_PER_LAYER, s = (ph - 1) % PH_PER_LAYER;
    const float* modl = modp + (size_t)l * 4 * 6144;
    const float* xin = (l == 0) ? p.in[I_X] : xs;
    switch (s) {
#ifndef NO_NORM
    case 0:
        phase_norm(p, lds, xin, p.in[I_NMG] + l * DM, modl, 0, 1024, hbuf, (const float*)(ws + WS_WSC) + (size_t)l * 12 * DM, (float*)(ws + WS_SCAL));
        break;
#endif
#ifndef NO_G1
    case 1: {
        pg8::EpiProj E{(bf16_t*)(ws + WS_PAB), (bf16_t*)(ws + WS_PC), (bf16_t*)(ws + WS_PZ)};
        run_gemm(lds, hbuf, (const bf16_t*)(ws + WS_WTIN) + (size_t)l * NPROJ * DM, MTOK, NPROJ, DM, E);
        break; }
#endif
#ifndef NO_PREP
    case 2: {
        if (my_bid() >= my_gdim() - 16) {
            const int bh = my_bid() - (my_gdim() - 16);
            if (bh >= 0 && bh < 16) fcum_unit(lds, bh, (const float*)(ws + WS_SCAL), p.in[I_FGB] + l * 4, (float*)(ws + WS_F));
        }
        for (int it = my_bid(); it < 2048; it += my_gdim()) {
            const int bh = it >> 7, n = it & 127, h = bh & 3;
            prep_unit(lds, bh, n, (const bf16_t*)(ws + WS_PC), (const float*)(ws + WS_SCAL), p.in[I_CONVW] + (size_t)l * 4 * 1536, p.in[I_ALOG][l * 4 + h], p.in[I_DTB][l * 4 + h],
                      ws + WS_PREP + (size_t)it * PREP_UNIT, (float*)(ws + WS_EGL));
        }
        break; }
#endif
#ifndef NO_MIX
    case 3: {
        unsigned* ctr = (unsigned*)(ws + WS_CTRL) + 8 + l;
        const bf16_t* pab = (const bf16_t*)(ws + WS_PAB);
        for (;;) {
            const int it = fetch_item(ctr, lds);
            if (it >= 32 + 512 + 512) break;
            if (it < 32) scan_unit(lds, it >> 1, it & 1, ws + WS_PREP, (const float*)(ws + WS_EGL), (float*)(ws + WS_PC));
            else if (it < 544) { const int j = it - 32, qb = 31 - (j >> 4), bh = j & 15, b = bh >> 2, h = bh & 3;
                attn_unit<0>(lds, b, qb, pab + 768 + h * 64, pab + 1024 + h * 64, pab + 1280 + h * 64, 1536, hbuf + 256 + h * 64, DM, (const float*)(ws + WS_F) + (size_t)bh * SEQ, nullptr); }
            else { const int j = it - 544, qb = j & 31, bh = j >> 5, b = bh >> 2, h = bh & 3;
                attn_unit<1>(lds, b, qb, pab + h * 64, pab + 256 + h * 64, pab + 512 + h * 64, 1536, hbuf + h * 64, DM, nullptr, p.in[I_REL] + (size_t)(l * 4 + h) * 320); }
        }
        break; }
#endif
#ifndef NO_FIN
    case 4:
        phase_finalize((const float*)(ws + WS_PC), (const bf16_t*)(ws + WS_PZ), p.in[I_GNG] + l * 128, hbuf);
        break;
#endif
#ifndef NO_G2
    case 5: {
        pg8::EpiRes E{xin, xs, modl + 2048, 0};
        run_gemm(lds, hbuf, (const bf16_t*)(ws + WS_WTOUT) + (size_t)l * DM * DM, MTOK, DM, DM, E);
        break; }
#endif
#ifndef NO_NORM
    case 6:
        phase_norm(p, lds, xs, p.in[I_NFG] + l * DM, modl, 3072, 4096, hbuf, nullptr, nullptr);
        break;
#endif
#ifndef NO_G3
    case 7: case 10: {
        const int half = (s == 10);
        pg8::EpiPlain E{(bf16_t*)(ws + WS_UH), NUP};
        run_gemm(lds, hbuf + (size_t)half * MHALF * DM, (const bf16_t*)(ws + WS_WTUP) + (size_t)l * NUP * DM, MHALF, NUP, DM, E);
        break; }
#endif
#ifndef NO_ACT
    case 8: case 11:
        phase_act((const bf16_t*)(ws + WS_UH), p.in[I_FCW] + (size_t)l * 3 * NUP, (bf16_t*)(ws + WS_ACT));
        break;
#endif
#ifndef NO_G4
    case 9: case 12: {
        const int half = (s == 12);
        pg8::EpiRes E{xs, xs, modl + 5120, half * MHALF};
        run_gemm(lds, (const bf16_t*)(ws + WS_ACT), (const bf16_t*)(ws + WS_WTDN) + (size_t)l * DM * DFF, MHALF, DM, DFF, E);
        break; }
#endif
    }
}

__global__ void __launch_bounds__(NTHR, 2) hybrid_fwd(Params p) {
    extern __shared__ __attribute__((aligned(16))) unsigned char lds[];
    for (int ph = p.ph_lo; ph < p.ph_hi; ++ph) {
        Params q = p;
#pragma unroll
        for (int i = 0; i < 18; ++i) asm volatile("" : "+s"(q.in[i]));
        asm volatile("" : "+s"(q.out), "+s"(q.ws));
        run_phase(q, lds, ph);
        if (ph + 1 < p.ph_hi) { cg::this_grid().sync(); }
    }
}

#ifndef N_LAUNCH_MODE
#define N_LAUNCH_MODE 1
#endif

extern "C" void kernel_launch(void* const* d_in, const int* in_sizes, int n_in, void* d_out, int out_size, void* d_ws, size_t ws_size, hipStream_t stream) {
    static int grid = 0;
    if (grid == 0) {
        if (n_in != 18 || out_size != MTOK * DM || ws_size < WS_END) { fprintf(stderr, "kernel_launch: unexpected shapes (n_in %d out %d ws %zu)\n", n_in, out_size, ws_size); grid = -1; return; }
        int dev = 0, cus = 0, per_cu = 0;
        hipGetDevice(&dev); hipDeviceGetAttribute(&cus, hipDeviceAttributeMultiprocessorCount, dev);
        if (hipFuncSetAttribute((const void*)hybrid_fwd, hipFuncAttributeMaxDynamicSharedMemorySize, LDS_TOTAL) != hipSuccess) { fprintf(stderr, "kernel_launch: hipFuncSetAttribute failed\n"); grid = -1; return; }
        if (hipOccupancyMaxActiveBlocksPerMultiprocessor(&per_cu, (const void*)hybrid_fwd, NTHR, LDS_TOTAL) != hipSuccess || per_cu < 1) { fprintf(stderr, "kernel_launch: occupancy query gave %d\n", per_cu); (void)hipGetLastError(); per_cu = 1; }
        grid = cus;
        if (grid <= 0) { grid = -1; return; }
    }
    if (grid < 0) return;
    Params p{};
    for (int i = 0; i < 18; ++i) p.in[i] = (const float*)d_in[i];
    p.out = (float*)d_out; p.ws = (unsigned char*)d_ws;
#if N_LAUNCH_MODE == 1
    p.ph_lo = 0; p.ph_hi = N_PHASES;
    void* args[] = {&p};
    hipError_t e = hipLaunchCooperativeKernel((const void*)hybrid_fwd, dim3(grid), dim3(NTHR), args, LDS_TOTAL, stream);
    if (e != hipSuccess) fprintf(stderr, "kernel_launch: cooperative launch failed: %s (grid %d)\n", hipGetErrorString(e), grid);
#else
    for (int ph = 0; ph < N_PHASES; ++ph) { p.ph_lo = ph; p.ph_hi = ph + 1; hipLaunchKernelGGL(hybrid_fwd, dim3(grid), dim3(NTHR), LDS_TOTAL, stream, p); }
#endif
}
```

```cpp
#include <hip/hip_runtime.h>
#include <hip/hip_cooperative_groups.h>
#include <cstdio>
#include <cstdint>
namespace cg = cooperative_groups;
__device__ __forceinline__ int my_tid() { int t = (int)threadIdx.x; asm volatile("" : "+v"(t)); return t; }
__device__ __forceinline__ int my_bid() { int t = (int)blockIdx.x; asm volatile("" : "+s"(t)); return t; }
__device__ __forceinline__ int my_gdim() { int t = (int)gridDim.x; asm volatile("" : "+s"(t)); return t; }
namespace pg8 {
#define PG8_LAS __attribute__((address_space(3)))
typedef unsigned short bf16_t;
typedef short bf16x8 __attribute__((ext_vector_type(8)));
typedef float f32x4 __attribute__((ext_vector_type(4)));
typedef unsigned u32x4 __attribute__((ext_vector_type(4)));
constexpr int BM = 256, BK = 64, HALF = 128, HTB = HALF * BK * 2  , STAGE_BYTES = 8 * HTB, NXCD = 8, WGM = 8;

__host__ __device__ __forceinline__ int lds_byte(int r, int c) { const int st = (r >> 4) * 2 + (c >> 5), rr = r & 15, cc = c & 31, ob = rr * 64 + cc * 2; return st * 1024 + (ob ^ (((ob >> 9) & 1) << 5)); }
__host__ __device__ __forceinline__ void stage_rc(int b, int& R, int& C) { const int st = b / 1024, sb = b % 1024, swz = sb ^ (((sb >> 9) & 1) << 5); R = (st >> 1) * 16 + swz / 64; C = (st & 1) * 32 + (swz % 64) / 2; }
__host__ __device__ __forceinline__ int perm32(int rho) { const int n = rho >> 4, i = rho & 15; return 8 * (i >> 2) + 4 * n + (i & 3); }

struct Unit { int pm, pn; };
struct Gemm { const bf16_t* A; const bf16_t* Bt; int M, N, K; };

struct StaticOrder {
    int nM, nN, nwg, G, c;
    __host__ __device__ void init(int M, int N, int G_, int c_) { nM = M / BM; nN = N / BM; nwg = nM * nN; G = G_; c = c_; }
    __host__ __device__ bool next(int i, Unit& u) const {
        const long L = (long)i * G + c; if (L >= nwg) return false;
        int wgid = (int)L; { const int q = nwg / NXCD, r = nwg % NXCD, xcd = wgid % NXCD, off = wgid / NXCD; wgid = (xcd < r ? xcd * (q + 1) : r * (q + 1) + (xcd - r) * q) + off; }
        const int nig = WGM * nN, gid = wgid / nig, fm = gid * WGM, gsz = (nM - fm) < WGM ? (nM - fm) : WGM;
        u.pm = fm + ((wgid % nig) % gsz); u.pn = (wgid % nig) / gsz; return true;
    }
    __device__ __forceinline__ void a_ready(const Unit&) const {}
    __device__ __forceinline__ void done(const Unit&) const {}
};
typedef float f32x2_t_ __attribute__((ext_vector_type(2))); typedef __bf16 bf16x2_t_ __attribute__((ext_vector_type(2)));
__device__ __forceinline__ unsigned cvt_pk_bf16(float lo, float hi) { f32x2_t_ v = {lo, hi}; bf16x2_t_ b = __builtin_convertvector(v, bf16x2_t_); return __builtin_bit_cast(unsigned, b); }
template <class Epi, class Sched, bool ALIGN_EPI = false, bool SP2 = false>
__device__ __forceinline__ void gemm_phase(PG8_LAS unsigned char* lds, const Gemm g, const Sched& S, const Epi& E) {
    const int tid = my_tid(), wid = __builtin_amdgcn_readfirstlane(tid >> 6), lane = tid & 63, wr = wid >> 2, wc = wid & 3, fr = lane & 15, fq = lane >> 4;
    const int K = g.K, nt = K / BK;
    unsigned voffA[2], voffB[2];
#pragma unroll
    for (int i = 0; i < 2; ++i) { int R, C; stage_rc(tid * 16 + i * 8192, R, C); const int Rb = Epi::PERM ? ((R & ~31) + perm32(R & 31)) : R;
        voffA[i] = (unsigned)(R * K + C) * 2u; voffB[i] = (unsigned)(Rb * K + C) * 2u; }
    const size_t kstep = (size_t)(BK * 2);
    const size_t hstep = (size_t)HALF * K * 2;
    const size_t tstep = 2 * hstep;
    const unsigned ldsw = (unsigned)wid * 1024u;
    const int aoff = lds_byte(wr * 64 + fr, fq * 8), boff = lds_byte(wc * 32 + fr, fq * 8);
#define PG8_SA(b, h) (((b) * 2 + (h)) * HTB)
#define PG8_SB(b, h) ((4 + (b) * 2 + (h)) * HTB)
#define PG8_STAGE(bufoff, gbase, voff) do { _Pragma("unroll") for (int _i = 0; _i < 2; ++_i) \
        __builtin_amdgcn_global_load_lds((const unsigned*)((const char*)(gbase) + (voff)[_i]), (PG8_LAS unsigned*)(lds + (bufoff) + ldsw + _i * 8192), 16, 0, 0); } while (0)
#define PG8_LDA(dst, b, h) do { _Pragma("unroll") for (int m = 0; m < 4; ++m) _Pragma("unroll") for (int k = 0; k < 2; ++k) dst[m][k] = *(const PG8_LAS bf16x8*)(lds + PG8_SA(b, h) + aoff + m * 2048 + k * 1024); } while (0)
#define PG8_LDB(dst, b, h) do { _Pragma("unroll") for (int n = 0; n < 2; ++n) _Pragma("unroll") for (int k = 0; k < 2; ++k) dst[n][k] = *(const PG8_LAS bf16x8*)(lds + PG8_SB(b, h) + boff + n * 2048 + k * 1024); } while (0)
#define PG8_MMA(ai, bj, At, Bt) do { __builtin_amdgcn_s_setprio(1); _Pragma("unroll") for (int m = 0; m < 4; ++m) _Pragma("unroll") for (int n = 0; n < 2; ++n) _Pragma("unroll") for (int k = 0; k < 2; ++k) \
        acc[ai][bj][m][n] = __builtin_amdgcn_mfma_f32_16x16x32_bf16(Bt[n][k], At[m][k], acc[ai][bj][m][n], 0, 0, 0); __builtin_amdgcn_s_setprio(0); } while (0)
#define PG8_WAIT_V(n) asm volatile("s_waitcnt vmcnt(" #n ")" ::: "memory")
#define PG8_WAIT_L(n) asm volatile("s_waitcnt lgkmcnt(" #n ")" ::: "memory")
#define PG8_BAR __builtin_amdgcn_s_barrier()
#define PG8_SCHED __builtin_amdgcn_sched_barrier(0)
    Unit cur, nxt; int ui = 0;
    if (!S.next(0, cur)) return;
    f32x4 acc[2][2][4][2];
#pragma unroll
    for (int a = 0; a < 2; ++a)
#pragma unroll
        for (int b = 0; b < 2; ++b)
#pragma unroll
            for (int m = 0; m < 4; ++m)
#pragma unroll
                for (int n = 0; n < 2; ++n) acc[a][b][m][n] = (f32x4){0.f, 0.f, 0.f, 0.f};
    bf16x8 At[4][2], B0[2][2], B1[2][2];
    const char* cA = (const char*)g.A + (size_t)cur.pm * tstep; const char* cB = (const char*)g.Bt + (size_t)cur.pn * tstep;
    S.a_ready(cur);
    if constexpr (SP2) {
        PG8_STAGE(PG8_SB(0, 0), cB, voffB); PG8_STAGE(PG8_SB(0, 1), cB + hstep, voffB); PG8_STAGE(PG8_SA(0, 0), cA, voffA); PG8_STAGE(PG8_SA(0, 1), cA + hstep, voffA);
        if (wr == 1) PG8_BAR;
        PG8_WAIT_V(2); PG8_BAR;
        PG8_STAGE(PG8_SB(1, 0), cB + kstep, voffB); PG8_STAGE(PG8_SA(1, 0), cA + kstep, voffA); PG8_STAGE(PG8_SB(1, 1), cB + hstep + kstep, voffB);
        PG8_WAIT_V(6); PG8_BAR;
    } else {
        PG8_STAGE(PG8_SB(0, 0), cB, voffB); PG8_STAGE(PG8_SA(0, 0), cA, voffA); PG8_STAGE(PG8_SB(0, 1), cB + hstep, voffB); PG8_STAGE(PG8_SA(0, 1), cA + hstep, voffA);
        if (wr == 1) PG8_BAR;
        PG8_WAIT_V(4); PG8_BAR;
        PG8_STAGE(PG8_SB(1, 0), cB + kstep, voffB); PG8_STAGE(PG8_SA(1, 0), cA + kstep, voffA); PG8_STAGE(PG8_SB(1, 1), cB + hstep + kstep, voffB);
        PG8_WAIT_V(6); PG8_BAR;
    }
    for (;;) {
        const bool has_next = S.next(ui + 1, nxt);
        const char* nA = has_next ? (const char*)g.A + (size_t)nxt.pm * tstep : cA; const char* nB = has_next ? (const char*)g.Bt + (size_t)nxt.pn * tstep : cB;
        for (int t = 0; t < nt; t += 2) {
            const bool last = (t == nt - 2);
            const char* a1 = cA + (size_t)(t + 1) * kstep;
            const char* a2 = last ? nA : cA + (size_t)(t + 2) * kstep; const char* b2 = last ? nB : cB + (size_t)(t + 2) * kstep;
            const char* a3 = a2 + kstep; const char* b3 = b2 + kstep;
            if (last && has_next) S.a_ready(nxt);
            if constexpr (SP2) {
            PG8_LDB(B0, 0, 0); PG8_LDB(B1, 0, 1); PG8_SCHED; PG8_LDA(At, 0, 0); PG8_STAGE(PG8_SA(1, 1), a1 + hstep, voffA);
            PG8_WAIT_V(8); PG8_WAIT_L(0); PG8_BAR; PG8_MMA(0, 0, At, B0); PG8_MMA(0, 1, At, B1); PG8_BAR; PG8_SCHED;
            PG8_LDA(At, 0, 1); PG8_STAGE(PG8_SB(0, 0), b2, voffB); PG8_STAGE(PG8_SB(0, 1), b2 + hstep, voffB); PG8_STAGE(PG8_SA(0, 0), a2, voffA);
            PG8_WAIT_V(8); PG8_WAIT_L(0); PG8_BAR; PG8_MMA(1, 0, At, B0); PG8_MMA(1, 1, At, B1); PG8_BAR; PG8_SCHED;
            PG8_LDB(B0, 1, 0); PG8_LDB(B1, 1, 1); PG8_SCHED; PG8_LDA(At, 1, 0); PG8_STAGE(PG8_SA(0, 1), a2 + hstep, voffA);
            PG8_WAIT_V(8); PG8_WAIT_L(0); PG8_BAR; PG8_MMA(0, 0, At, B0); PG8_MMA(0, 1, At, B1); PG8_BAR; PG8_SCHED;
            PG8_LDA(At, 1, 1); PG8_STAGE(PG8_SB(1, 0), b3, voffB); PG8_STAGE(PG8_SB(1, 1), b3 + hstep, voffB); PG8_STAGE(PG8_SA(1, 0), a3, voffA);
            PG8_WAIT_V(8); PG8_WAIT_L(0); PG8_BAR; PG8_MMA(1, 0, At, B0); PG8_MMA(1, 1, At, B1); PG8_BAR; PG8_SCHED;
            } else {
            PG8_LDB(B0, 0, 0); PG8_SCHED; PG8_LDA(At, 0, 0); PG8_STAGE(PG8_SA(1, 1), a1 + hstep, voffA);
            PG8_WAIT_L(8); PG8_BAR; PG8_WAIT_L(0); PG8_MMA(0, 0, At, B0); PG8_BAR; PG8_SCHED;
            PG8_LDB(B1, 0, 1); PG8_STAGE(PG8_SB(0, 0), b2, voffB);
            PG8_BAR; PG8_WAIT_L(0); PG8_MMA(0, 1, At, B1); PG8_BAR;
            PG8_LDA(At, 0, 1); PG8_STAGE(PG8_SA(0, 0), a2, voffA);
            PG8_BAR; PG8_WAIT_L(0); PG8_MMA(1, 0, At, B0); PG8_BAR; PG8_SCHED;
            PG8_STAGE(PG8_SB(0, 1), b2 + hstep, voffB);
            PG8_WAIT_V(6); PG8_BAR; PG8_MMA(1, 1, At, B1); PG8_BAR;
            PG8_LDB(B0, 1, 0); PG8_SCHED; PG8_LDA(At, 1, 0); PG8_STAGE(PG8_SA(0, 1), a2 + hstep, voffA);
            PG8_WAIT_L(8); PG8_BAR; PG8_WAIT_L(0); PG8_MMA(0, 0, At, B0); PG8_BAR; PG8_SCHED;
            PG8_LDB(B1, 1, 1); PG8_STAGE(PG8_SB(1, 0), b3, voffB);
            PG8_BAR; PG8_WAIT_L(0); PG8_MMA(0, 1, At, B1); PG8_BAR;
            PG8_LDA(At, 1, 1); PG8_STAGE(PG8_SA(1, 0), a3, voffA);
            PG8_BAR; PG8_WAIT_L(0); PG8_MMA(1, 0, At, B0); PG8_BAR; PG8_SCHED;
            PG8_STAGE(PG8_SB(1, 1), b3 + hstep, voffB);
            PG8_WAIT_V(6); PG8_BAR; PG8_MMA(1, 1, At, B1); PG8_BAR;
            }
        }
        if constexpr (ALIGN_EPI) { if (wr == 0) PG8_BAR; }
        if constexpr (!Epi::AFTER_DRAIN) { E(acc, cur, wr, wc, fr, fq); S.done(cur); }
        if (!has_next) break;
#pragma unroll
        for (int a = 0; a < 2; ++a)
#pragma unroll
            for (int b = 0; b < 2; ++b)
#pragma unroll
                for (int m = 0; m < 4; ++m)
#pragma unroll
                    for (int n = 0; n < 2; ++n) acc[a][b][m][n] = (f32x4){0.f, 0.f, 0.f, 0.f};
        cur = nxt; cA = nA; cB = nB; ++ui;
        if constexpr (ALIGN_EPI) { if (wr == 1) PG8_BAR; }
    }
    PG8_WAIT_V(0);
    if constexpr (!ALIGN_EPI) { if (wr == 0) PG8_BAR; }
    PG8_BAR;
    if constexpr (Epi::AFTER_DRAIN) { E.fused(acc, cur, wr, wc, fr, fq, lds, wid, lane); S.done(cur); }
#undef PG8_SA
#undef PG8_SB
#undef PG8_STAGE
#undef PG8_LDA
#undef PG8_LDB
#undef PG8_MMA
#undef PG8_WAIT_V
#undef PG8_WAIT_L
#undef PG8_BAR
#undef PG8_SCHED
}
}
#define XB_TMO      128
#define XB_XCNT(j)  (256  + 64 * (j))
#define XB_XSUB(j)  (1280 + 64 * (j))
#define XB_XGEN(j)  (2304 + 64 * (j))
#define XB_TOP      3328
#define XB_TOPGEN   3392
#define XCD_BAR_WORDS 3456
#define XB_SPIN_CAP (1u << 18)
#define LAS __attribute__((address_space(3)))

__device__ __forceinline__ unsigned xb_ld(unsigned* p)              { return __hip_atomic_load(p, __ATOMIC_RELAXED, __HIP_MEMORY_SCOPE_AGENT); }
__device__ __forceinline__ unsigned xb_add(unsigned* p, unsigned v) { return __hip_atomic_fetch_add(p, v, __ATOMIC_RELAXED, __HIP_MEMORY_SCOPE_AGENT); }
__device__ __forceinline__ unsigned xb_xcc_id() { return (unsigned)__builtin_amdgcn_s_getreg((3 << 11) | 20) & 0xFu; }
#define XB_SPIN(cond, bar) do { unsigned _sp = 0; while (cond) { __builtin_amdgcn_s_sleep(1); \
    if ((++_sp & 255u) == 0u) { if (xb_ld(&(bar)[XB_TMO])) break; if (_sp > XB_SPIN_CAP) { atomicAdd(&(bar)[XB_TMO], 1u); break; } } } } while (0)

struct XcdBarrier {
    unsigned* bar; unsigned x;
    volatile LAS unsigned* st;
};

__device__ __forceinline__ XcdBarrier xcd_barrier_post(unsigned* bar, volatile LAS unsigned* st) {
    XcdBarrier b; b.bar = bar; b.x = xb_xcc_id(); b.st = st;
    if (threadIdx.x == 0) (void)xb_add(&bar[XB_XCNT(b.x)], 1u);
    return b;
}
__device__ __forceinline__ void xcd_barrier_complete(unsigned* bar, unsigned x, unsigned& nloc, unsigned& nx) {
    const unsigned G = gridDim.x * gridDim.y * gridDim.z;
    unsigned sum, cnt, mine, sp = 0u;
    for (;;) {
        sum = 0u; cnt = 0u; mine = 0u;
#pragma unroll
        for (unsigned j = 0; j < 16; ++j) { const unsigned c = xb_ld(&bar[XB_XCNT(j)]); sum += c; cnt += (c > 0u) ? 1u : 0u; mine = (j == x) ? c : mine; }
        if (sum == G) break;
        __builtin_amdgcn_s_sleep(1);
        if ((++sp & 255u) == 0u) { if (xb_ld(&bar[XB_TMO])) break; if (sp > XB_SPIN_CAP) { atomicAdd(&bar[XB_TMO], 1u); break; } }
    }
    nloc = mine > 0u ? mine : 1u; nx = cnt > 0u ? cnt : 1u;
}

__device__ __forceinline__ void xcd_barrier(const XcdBarrier& b) {
    asm volatile("s_waitcnt vmcnt(0)" ::: "memory");
    __syncthreads();
    if (threadIdx.x == 0) {
        unsigned* bar = b.bar;
        __builtin_amdgcn_s_waitcnt(0);
        unsigned nloc = b.st[0], nx = b.st[1];
        if (nloc == 0u) { xcd_barrier_complete(bar, b.x, nloc, nx); b.st[0] = nloc; b.st[1] = nx; }
        const unsigned old = xb_add(&bar[XB_XSUB(b.x)], 1u);
        const unsigned gen = old / nloc;
        if (old + 1u == (gen + 1u) * nloc) {
            __builtin_amdgcn_fence(__ATOMIC_RELEASE, "agent");
            asm volatile("s_waitcnt vmcnt(0)" ::: "memory");
            const unsigned og = xb_add(&bar[XB_TOP], 1u);
            const unsigned tg = og / nx;
            if (og + 1u == (tg + 1u) * nx) xb_add(&bar[XB_TOPGEN], 1u);
            else XB_SPIN(xb_ld(&bar[XB_TOPGEN]) == tg, bar);
            __builtin_amdgcn_fence(__ATOMIC_ACQUIRE, "agent");
            xb_add(&bar[XB_XGEN(b.x)], 1u);
            asm volatile("s_waitcnt vmcnt(0)" ::: "memory");
        } else {
            XB_SPIN(xb_ld(&bar[XB_XGEN(b.x)]) == gen, bar);
            __builtin_amdgcn_fence(__ATOMIC_ACQUIRE, "agent");
            asm volatile("s_waitcnt vmcnt(0)" ::: "memory");
        }
    }
    __syncthreads();
}


typedef unsigned short bf16_t;
typedef short bf16x8 __attribute__((ext_vector_type(8)));
typedef float f32x4 __attribute__((ext_vector_type(4)));
typedef unsigned u32x4 __attribute__((ext_vector_type(4)));
typedef unsigned u32x2 __attribute__((ext_vector_type(2)));

constexpr int NB = 4, SEQ = 8192, DM = 1024, MTOK = NB * SEQ, DEPTH = 2;
constexpr int DIN = 3596, NPROJ = 3584, DFF = 2816, NUP = 5632;
constexpr int NTHR = 512;
constexpr float LOG2E = 1.4426950408889634f;
constexpr float QSCALE = 0.125f * LOG2E;
constexpr float EPS = 1e-6f;
constexpr int MHALF = MTOK / 2;

constexpr size_t MiB = 1048576;
constexpr size_t WS_CTRL = 0;
constexpr size_t WS_MOD  = 4096;
constexpr size_t WS_WSC  = WS_MOD + 2 * 4 * 6144 * 4;
constexpr size_t WS_F    = WS_WSC + 2 * 12 * 1024 * 4;
constexpr size_t WS_EGL  = WS_F + 16 * 8192 * 4;
constexpr size_t WS_KN   = 835584;
constexpr size_t WS_AB   = 843776;
constexpr size_t WS_FLG  = 905216;
constexpr size_t WS_XB   = 921600;
constexpr size_t WS_SCAL = 1 * MiB;
constexpr size_t WS_WTIN = 3 * MiB;
constexpr size_t WS_WTOUT = 17 * MiB;
constexpr size_t WS_WTUP = 21 * MiB;
constexpr size_t WS_WTDN = 43 * MiB;
constexpr size_t WS_HBUF = 54 * MiB;
constexpr size_t WS_R1   = 118 * MiB;
constexpr size_t WS_PAB  = WS_R1;
constexpr size_t WS_PC   = WS_R1 + 96 * MiB;
constexpr size_t WS_PZ   = WS_R1 + 192 * MiB;
constexpr size_t WS_PREP = WS_R1 + 224 * MiB;
constexpr size_t WS_UH   = WS_R1;
constexpr size_t WS_ACT  = WS_R1 + 176 * MiB;
constexpr size_t WS_HALO = WS_R1 + 352 * MiB;
constexpr size_t WS_END  = WS_R1 + 368 * MiB;
constexpr int PREP_UNIT = 73728;
constexpr int LDS_BYTES = 156672;
constexpr int LDS_SLOT_C = 156672;

struct Params {
    const float* in[18];
    float* out;
    unsigned char* ws;
    int ph_lo, ph_hi;
};
enum { I_X = 0, I_C, I_ADAW, I_ADAB, I_NMG, I_NFG, I_WIN, I_WOUT, I_REL, I_FGB, I_CONVW, I_ALOG, I_DTB, I_GNG, I_WUP, I_FCW, I_WDN, I_FNG };

__device__ __forceinline__ float bf2f(unsigned v) { return __uint_as_float(v << 16); }
__device__ __forceinline__ unsigned pack2(float lo, float hi) { return pg8::cvt_pk_bf16(lo, hi); }
__device__ __forceinline__ float dpp_row_shr_(float v, int ctrl_sel) {
    const int iv = __builtin_bit_cast(int, v); int r;
    switch (ctrl_sel) { case 1: r = __builtin_amdgcn_update_dpp(0, iv, 0x111, 0xf, 0xf, true); break; case 2: r = __builtin_amdgcn_update_dpp(0, iv, 0x112, 0xf, 0xf, true); break;
                        case 4: r = __builtin_amdgcn_update_dpp(0, iv, 0x114, 0xf, 0xf, true); break; default: r = __builtin_amdgcn_update_dpp(0, iv, 0x118, 0xf, 0xf, true); break; }
    return __builtin_bit_cast(float, r);
}
__device__ __forceinline__ float wave_sum(float v) {
    v += dpp_row_shr_(v, 1); v += dpp_row_shr_(v, 2); v += dpp_row_shr_(v, 4); v += dpp_row_shr_(v, 8);
    v += __builtin_bit_cast(float, __builtin_amdgcn_update_dpp(0, __builtin_bit_cast(int, v), 0x142, 0xa, 0xf, false));
    v += __builtin_bit_cast(float, __builtin_amdgcn_update_dpp(0, __builtin_bit_cast(int, v), 0x143, 0xc, 0xf, false));
    return __builtin_bit_cast(float, __builtin_amdgcn_readlane(__builtin_bit_cast(int, v), 63));
}
__device__ __forceinline__ float silu_f(float x) { return x * __builtin_amdgcn_rcpf(1.0f + __expf(-x)); }
__device__ __forceinline__ float softplus_f(float x) { return fmaxf(x, 0.f) + log1pf(__expf(-fabsf(x))); }
__device__ __forceinline__ void unpack8(const u32x4 v, float* f) {
#pragma unroll
    for (int i = 0; i < 4; ++i) { f[2 * i] = __uint_as_float(v[i] << 16); f[2 * i + 1] = __uint_as_float(v[i] & 0xffff0000u); }
}
__device__ __forceinline__ void handoff_publish(unsigned* flag, unsigned val) {
    asm volatile("s_waitcnt vmcnt(0)" ::: "memory");
    __syncthreads();
    if (threadIdx.x == 0) {
        __builtin_amdgcn_fence(__ATOMIC_RELEASE, "agent");
        asm volatile("s_waitcnt vmcnt(0)" ::: "memory");
        __hip_atomic_store(flag, val, __ATOMIC_RELAXED, __HIP_MEMORY_SCOPE_AGENT);
    }
}
__device__ __forceinline__ void handoff_publish_wt(unsigned* flag, unsigned val) {
    asm volatile("s_waitcnt vmcnt(0)" ::: "memory");
    __syncthreads();
    if (threadIdx.x == 0) __hip_atomic_store(flag, val, __ATOMIC_RELAXED, __HIP_MEMORY_SCOPE_AGENT);
}
__device__ __forceinline__ void handoff_wait_one(const unsigned* flag, unsigned val) {
    if (threadIdx.x == 0) {
        while (__hip_atomic_load(flag, __ATOMIC_RELAXED, __HIP_MEMORY_SCOPE_AGENT) < val) __builtin_amdgcn_s_sleep(4);
        __builtin_amdgcn_fence(__ATOMIC_ACQUIRE, "agent");
        asm volatile("s_waitcnt vmcnt(0)" ::: "memory");
    }
    __syncthreads();
}
#define MFMA16(a, b, c) __builtin_amdgcn_mfma_f32_16x16x32_bf16((a), (b), (c), 0, 0, 0)

namespace pg8 {
struct EpiProj {
    static constexpr bool PERM = true, AFTER_DRAIN = false;
    bf16_t* pab; bf16_t* pc; bf16_t* pz;
    __device__ __forceinline__ void operator()(const f32x4 (&acc)[2][2][4][2], const Unit& u, int wr, int wc, int fr, int fq) const {
        bf16_t* base; int ldc, colt; float sc = 1.f;
        if (u.pn < 6) { base = pab; ldc = 1536; colt = u.pn * 256; if (u.pn == 0 || u.pn == 3) sc = QSCALE; }
        else if (u.pn < 12) { base = pc; ldc = 1536; colt = (u.pn - 6) * 256; }
        else { base = pz; ldc = 512; colt = (u.pn - 12) * 256; }
        const int row0 = u.pm * BM + wr * 64 + fr, col0 = colt + wc * 32 + 8 * fq;
#pragma unroll
        for (int ai = 0; ai < 2; ++ai)
#pragma unroll
            for (int m = 0; m < 4; ++m) { bf16_t* rowp = base + (size_t)(row0 + ai * HALF + m * 16) * ldc + col0;
#pragma unroll
                for (int bj = 0; bj < 2; ++bj) { const f32x4 v0 = acc[ai][bj][m][0] * sc, v1 = acc[ai][bj][m][1] * sc;
                    u32x4 w; w.x = cvt_pk_bf16(v0[0], v0[1]); w.y = cvt_pk_bf16(v0[2], v0[3]); w.z = cvt_pk_bf16(v1[0], v1[1]); w.w = cvt_pk_bf16(v1[2], v1[3]);
                    *(u32x4*)(rowp + bj * HALF) = w; } }
    }
};
struct EpiPlain {
    static constexpr bool PERM = true, AFTER_DRAIN = false;
    bf16_t* O; int ldc;
    __device__ __forceinline__ void operator()(const f32x4 (&acc)[2][2][4][2], const Unit& u, int wr, int wc, int fr, int fq) const {
        const int row0 = u.pm * BM + wr * 64 + fr, col0 = u.pn * BM + wc * 32 + 8 * fq;
#pragma unroll
        for (int ai = 0; ai < 2; ++ai)
#pragma unroll
            for (int m = 0; m < 4; ++m) { bf16_t* rowp = O + (size_t)(row0 + ai * HALF + m * 16) * ldc + col0;
#pragma unroll
                for (int bj = 0; bj < 2; ++bj) { const f32x4 v0 = acc[ai][bj][m][0], v1 = acc[ai][bj][m][1];
                    u32x4 w; w.x = cvt_pk_bf16(v0[0], v0[1]); w.y = cvt_pk_bf16(v0[2], v0[3]); w.z = cvt_pk_bf16(v1[0], v1[1]); w.w = cvt_pk_bf16(v1[2], v1[3]);
                    *(u32x4*)(rowp + bj * HALF) = w; } }
    }
};
struct EpiRes {
    static constexpr bool PERM = false, AFTER_DRAIN = false;
    const float* base; float* out; const float* gate; int row_off;
    __device__ __forceinline__ void operator()(const f32x4 (&acc)[2][2][4][2], const Unit& u, int wr, int wc, int fr, int fq) const {
        const int col0 = u.pn * BM + wc * 32 + 4 * fq;
        const int rbase = row_off + u.pm * BM;
        const float* gp = gate + (size_t)(rbase >> 13) * 6144 + col0;
        f32x4 gv[2][2];
#pragma unroll
        for (int bj = 0; bj < 2; ++bj)
#pragma unroll
            for (int n = 0; n < 2; ++n) gv[bj][n] = *(const f32x4*)(gp + bj * HALF + n * 16);
#pragma unroll
        for (int ai = 0; ai < 2; ++ai) {
            f32x4 bs[4][2][2];
#pragma unroll
            for (int m = 0; m < 4; ++m) { const size_t off = (size_t)(rbase + ai * HALF + wr * 64 + m * 16 + fr) * 1024 + col0;
#pragma unroll
                for (int bj = 0; bj < 2; ++bj)
#pragma unroll
                    for (int n = 0; n < 2; ++n) bs[m][bj][n] = *(const f32x4*)(base + off + bj * HALF + n * 16); }
            __builtin_amdgcn_sched_barrier(0);
#pragma unroll
            for (int m = 0; m < 4; ++m) { const size_t off = (size_t)(rbase + ai * HALF + wr * 64 + m * 16 + fr) * 1024 + col0;
#pragma unroll
                for (int bj = 0; bj < 2; ++bj)
#pragma unroll
                    for (int n = 0; n < 2; ++n) *(f32x4*)(out + off + bj * HALF + n * 16) = bs[m][bj][n] + gv[bj][n] * acc[ai][bj][m][n]; }
            __builtin_amdgcn_sched_barrier(0);
        }
    }
};

__device__ __forceinline__ float dpp_ror1(float v) { return __builtin_bit_cast(float, __builtin_amdgcn_update_dpp(0, __builtin_bit_cast(int, v), 0x121, 0xf, 0xf, false)); }
__device__ __forceinline__ float dpp_ror2(float v) { return __builtin_bit_cast(float, __builtin_amdgcn_update_dpp(0, __builtin_bit_cast(int, v), 0x122, 0xf, 0xf, false)); }
struct EpiAct {
    static constexpr bool PERM = true, AFTER_DRAIN = false;
    bf16_t* act; const float* cw; float* halo; float* xch;
    __device__ __forceinline__ void operator()(const f32x4 (&acc)[2][2][4][2], const Unit& u, int wr, int wc, int fr, int fq) const {
        const int wid = wr * 4 + wc;
        float* myx = xch + wid * 256;
        if (fr >= 14) {
#pragma unroll
            for (int ai = 0; ai < 2; ++ai)
#pragma unroll
                for (int bj = 0; bj < 2; ++bj)
#pragma unroll
                    for (int n = 0; n < 2; ++n) *(f32x4*)(myx + (ai * 2 + (fr - 14)) * 64 + bj * 32 + fq * 8 + n * 4) = acc[ai][bj][3][n];
        }
        asm volatile("s_waitcnt lgkmcnt(0)\n\ts_barrier" ::: "memory");
        const int colj = u.pn * 128 + wc * 32 + 8 * fq;
        float* hb = halo + (size_t)(u.pm * 22 + u.pn) * 1024 + wc * 32 + 8 * fq;
#pragma unroll
        for (int n = 0; n < 2; ++n) {
            f32x4 wgt[3][2];
#pragma unroll
            for (int i = 0; i < 3; ++i)
#pragma unroll
                for (int bj = 0; bj < 2; ++bj) wgt[i][bj] = *(const f32x4*)(cw + i * 5632 + bj * 2816 + colj + 4 * n);
#pragma unroll
            for (int ai = 0; ai < 2; ++ai) {
                const bool top = (wr == 0 && ai == 0);
                f32x4 h1[2], h2[2];
                const float* sx = xch + (wr == 1 ? wc : 4 + wc) * 256 + (wr == 1 ? ai * 2 : 0) * 64 + fq * 8 + n * 4;
#pragma unroll
                for (int bj = 0; bj < 2; ++bj) {
                    if (!top) { h2[bj] = *(const f32x4*)(sx + bj * 32); h1[bj] = *(const f32x4*)(sx + 64 + bj * 32); }
                    else { h2[bj] = (f32x4){0.f, 0.f, 0.f, 0.f}; h1[bj] = (f32x4){0.f, 0.f, 0.f, 0.f}; }
                }
#pragma unroll
                for (int m = 0; m < 4; ++m) {
                    float cv[2][4];
#pragma unroll
                    for (int bj = 0; bj < 2; ++bj)
#pragma unroll
                        for (int e = 0; e < 4; ++e) {
                            const float x = acc[ai][bj][m][n][e];
                            const float r1s = dpp_ror1(x), r2s = dpp_ror2(x);
                            float r1p, r2p;
                            if (m > 0) { const float xp = acc[ai][bj][m > 0 ? m - 1 : 0][n][e]; r1p = dpp_ror1(xp); r2p = dpp_ror2(xp); }
                            else { r1p = h1[bj][e]; r2p = (fr == 0) ? h2[bj][e] : h1[bj][e]; }
                            const float p1 = (fr == 0) ? r1p : r1s, p2 = (fr < 2) ? r2p : r2s;
                            cv[bj][e] = wgt[0][bj][e] * p2 + wgt[1][bj][e] * p1 + wgt[2][bj][e] * x;
                        }
                    const int r = u.pm * BM + ai * HALF + wr * 64 + m * 16 + fr;
                    if (top && m == 0 && fr < 2) {
#pragma unroll
                        for (int bj = 0; bj < 2; ++bj) *(f32x4*)(hb + fr * 256 + bj * 128 + 4 * n) = acc[0][bj][0][n];
                    } else {
                        float o[4];
#pragma unroll
                        for (int c = 0; c < 4; ++c) { const float g = cv[0][c]; o[c] = g * __builtin_amdgcn_rcpf(1.0f + __expf(-g)) * cv[1][c]; }
                        u32x2 w; w.x = cvt_pk_bf16(o[0], o[1]); w.y = cvt_pk_bf16(o[2], o[3]);
                        *(u32x2*)(act + (size_t)r * 2816 + colj + 4 * n) = w;
                    }
                }
            }
        }
        if (wr == 1 && fr >= 14) {
#pragma unroll
            for (int bj = 0; bj < 2; ++bj)
#pragma unroll
                for (int n = 0; n < 2; ++n) *(f32x4*)(hb + (2 + fr - 14) * 256 + bj * 128 + 4 * n) = acc[1][bj][3][n];
        }
    }
};
}

__device__ __forceinline__ void transpose_tile(float* tile  , const float* src, int lds_, int scol0, int k0, bf16_t* dst, int ldd, int drow0) {
    const int tid = my_tid();
#pragma unroll
    for (int i = 0; i < 2; ++i) { const int idx = tid + NTHR * i, kk = idx >> 4, n4 = (idx & 15) * 4;
        const f32x4 v = *(const f32x4*)(src + (size_t)(k0 + kk) * lds_ + scol0 + n4);
        tile[kk * 65 + n4] = v[0]; tile[kk * 65 + n4 + 1] = v[1]; tile[kk * 65 + n4 + 2] = v[2]; tile[kk * 65 + n4 + 3] = v[3]; }
    __syncthreads();
    { const int nn = tid >> 3, k8 = (tid & 7) * 8;
        u32x4 w;
        w.x = pack2(tile[(k8 + 0) * 65 + nn], tile[(k8 + 1) * 65 + nn]); w.y = pack2(tile[(k8 + 2) * 65 + nn], tile[(k8 + 3) * 65 + nn]);
        w.z = pack2(tile[(k8 + 4) * 65 + nn], tile[(k8 + 5) * 65 + nn]); w.w = pack2(tile[(k8 + 6) * 65 + nn], tile[(k8 + 7) * 65 + nn]);
        *(u32x4*)(dst + (size_t)(drow0 + nn) * ldd + k0 + k8) = w; }
    __syncthreads();
}

__device__ void phase_prologue(const Params& p, unsigned char* lds) {
    const int tid = my_tid();
    float* tile = (float*)lds;
    if (my_bid() == 0 && tid < 64) ((unsigned*)(p.ws + WS_CTRL))[tid] = 0u;
    constexpr int T_IN = 16 * 56, T_OUT = 16 * 16, T_UP = 16 * 88, T_DN = 44 * 16, T_L = T_IN + T_OUT + T_UP + T_DN;
    constexpr int N_T = 2 * T_L, N_MOD = 2 * 96, N_WSC = 24, N_ALL = N_T + N_MOD + N_WSC;
    {
        struct TD { const float* src; bf16_t* dst; int ldsrc, ldd; };
        auto tdesc = [&](int it) -> TD {
            const int l = it / T_L; int r = it % T_L;
            if (r < T_IN) { const int kt = r / 56, nt = r % 56, d0 = nt * 64; const int s0 = d0 < 1536 ? d0 : (d0 < 3072 ? d0 + 4 : d0 + 12);
                return TD{p.in[I_WIN] + (size_t)l * DM * DIN + (size_t)(kt * 64) * DIN + s0, (bf16_t*)(p.ws + WS_WTIN) + (size_t)l * NPROJ * DM + (size_t)d0 * DM + kt * 64, DIN, DM}; }
            if ((r -= T_IN) < T_OUT) { const int kt = r / 16, nt = r % 16;
                return TD{p.in[I_WOUT] + (size_t)l * DM * DM + (size_t)(kt * 64) * DM + nt * 64, (bf16_t*)(p.ws + WS_WTOUT) + (size_t)l * DM * DM + (size_t)(nt * 64) * DM + kt * 64, DM, DM}; }
            if ((r -= T_OUT) < T_UP) { const int kt = r / 88, nt = r % 88; const int d0 = nt * 64, pn = d0 >> 8, w = d0 & 255, s0 = w < 128 ? pn * 128 + w : DFF + pn * 128 + (w - 128);
                return TD{p.in[I_WUP] + (size_t)l * DM * NUP + (size_t)(kt * 64) * NUP + s0, (bf16_t*)(p.ws + WS_WTUP) + (size_t)l * NUP * DM + (size_t)d0 * DM + kt * 64, NUP, DM}; }
            r -= T_UP; const int kt = r / 16, nt = r % 16;
            return TD{p.in[I_WDN] + (size_t)l * DFF * DM + (size_t)(kt * 64) * DM + nt * 64, (bf16_t*)(p.ws + WS_WTDN) + (size_t)l * DM * DFF + (size_t)(nt * 64) * DFF + kt * 64, DM, DFF};
        };
        const int kk0 = tid >> 4, n4 = (tid & 15) * 4;
        const int nn = tid >> 3, k8 = (tid & 7) * 8;
        int it = my_bid(); TD d{nullptr, nullptr, 0, 0}; f32x4 v0 = (f32x4){0.f, 0.f, 0.f, 0.f}, v1 = v0;
        if (it < N_T) { d = tdesc(it); v0 = *(const f32x4*)(d.src + (size_t)kk0 * d.ldsrc + n4); v1 = *(const f32x4*)(d.src + (size_t)(kk0 + 32) * d.ldsrc + n4); }
        while (it < N_T) {
            const int itn = it + my_gdim(); TD dn{nullptr, nullptr, 0, 0}; f32x4 w0 = (f32x4){0.f, 0.f, 0.f, 0.f}, w1 = w0;
            if (itn < N_T) { dn = tdesc(itn); w0 = *(const f32x4*)(dn.src + (size_t)kk0 * dn.ldsrc + n4); w1 = *(const f32x4*)(dn.src + (size_t)(kk0 + 32) * dn.ldsrc + n4); }
            tile[kk0 * 65 + n4] = v0[0]; tile[kk0 * 65 + n4 + 1] = v0[1]; tile[kk0 * 65 + n4 + 2] = v0[2]; tile[kk0 * 65 + n4 + 3] = v0[3];
            tile[(kk0 + 32) * 65 + n4] = v1[0]; tile[(kk0 + 32) * 65 + n4 + 1] = v1[1]; tile[(kk0 + 32) * 65 + n4 + 2] = v1[2]; tile[(kk0 + 32) * 65 + n4 + 3] = v1[3];
            __syncthreads();
            u32x4 w;
            w.x = pack2(tile[(k8 + 0) * 65 + nn], tile[(k8 + 1) * 65 + nn]); w.y = pack2(tile[(k8 + 2) * 65 + nn], tile[(k8 + 3) * 65 + nn]);
            w.z = pack2(tile[(k8 + 4) * 65 + nn], tile[(k8 + 5) * 65 + nn]); w.w = pack2(tile[(k8 + 6) * 65 + nn], tile[(k8 + 7) * 65 + nn]);
            *(u32x4*)(d.dst + (size_t)nn * d.ldd + k8) = w;
            __syncthreads();
            it = itn; d = dn; v0 = w0; v1 = w1;
        }
    }
    for (int it = my_bid(); it < N_ALL; it += my_gdim()) {
        if (it < N_T) {
            continue;
        } else if (it < N_T + N_MOD) {
            const int r = it - N_T, l = r / 96, n0 = (r % 96) * 64, kg = tid >> 4, c4 = (tid & 15) * 4;
            const float* aw = p.in[I_ADAW] + (size_t)l * DM * 6144 + n0 + c4; const float* cc = p.in[I_C];
            f32x4 ac[4];
#pragma unroll
            for (int b = 0; b < 4; ++b) ac[b] = (f32x4){0.f, 0.f, 0.f, 0.f};
            for (int k0 = kg; k0 < DM; k0 += 256) {
                f32x4 wv[8]; float cv[4][8];
#pragma unroll
                for (int u = 0; u < 8; ++u) wv[u] = *(const f32x4*)(aw + (size_t)(k0 + 32 * u) * 6144);
#pragma unroll
                for (int b = 0; b < 4; ++b)
#pragma unroll
                    for (int u = 0; u < 8; ++u) cv[b][u] = cc[b * DM + k0 + 32 * u];
#pragma unroll
                for (int u = 0; u < 8; ++u)
#pragma unroll
                    for (int b = 0; b < 4; ++b) ac[b] += wv[u] * silu_f(cv[b][u]);
            }
            float* red = tile;
#pragma unroll
            for (int b = 0; b < 4; ++b) *(f32x4*)(red + (kg * 4 + b) * 64 + c4) = ac[b];
            __syncthreads();
            if (tid < 256) { const int b = tid >> 6, col = tid & 63; float s = 0.f;
#pragma unroll
                for (int g = 0; g < 32; ++g) s += red[(g * 4 + b) * 64 + col];
                ((float*)(p.ws + WS_MOD))[((size_t)l * 4 + b) * 6144 + n0 + col] = s + p.in[I_ADAB][(size_t)l * 6144 + n0 + col]; }
            __syncthreads();
        } else {
            const int r = it - N_T - N_MOD, l = r / 12, j = r % 12; const int sc = j < 4 ? 1536 + j : (j < 8 ? 3076 + (j - 4) : 3080 + (j - 8));
            float* dst = (float*)(p.ws + WS_WSC) + ((size_t)l * 12 + j) * DM; const float* src = p.in[I_WIN] + (size_t)l * DM * DIN + sc;
            for (int k = tid; k < DM; k += NTHR) dst[k] = src[(size_t)k * DIN];
        }
    }
}

__device__ __forceinline__ void phase_norm(const Params& p, unsigned char* lds, const float* __restrict__ xin, const float* g, const float* mod  , int shift_off, int scale_off, bf16_t* __restrict__ hout, const float* wsc  , float* scal) {
    const int tid = my_tid(), wid = tid >> 6, lane = tid & 63;
    float* wl = (float*)lds;
    if (wsc) { for (int i = tid; i < 12 * DM; i += NTHR) wl[i] = wsc[i]; __syncthreads(); }
    const int gw = my_bid() * 8 + wid, nw = my_gdim() * 8;
    for (int rb = gw * 4; rb < MTOK; rb += nw * 4) {
        const int b = rb >> 13;
        float cs[16], sh[16];
#pragma unroll
        for (int i = 0; i < 2; ++i)
#pragma unroll
            for (int j = 0; j < 8; ++j) { const int k = i * 512 + lane * 8 + j; cs[i * 8 + j] = g[k] * (1.0f + mod[(size_t)b * 6144 + scale_off + k]); sh[i * 8 + j] = mod[(size_t)b * 6144 + shift_off + k]; }
        { const int r4 = 0;
            f32x4 xq[4][4];
#pragma unroll
            for (int q = 0; q < 4; ++q) { const float* xp = xin + (size_t)(rb + r4 + q) * DM + lane * 8;
                xq[q][0] = __builtin_nontemporal_load((const f32x4*)xp); xq[q][1] = __builtin_nontemporal_load((const f32x4*)(xp + 4)); xq[q][2] = __builtin_nontemporal_load((const f32x4*)(xp + 512)); xq[q][3] = __builtin_nontemporal_load((const f32x4*)(xp + 516)); }
#pragma unroll
            for (int q = 0; q < 4; ++q) {
            const int row = rb + r4 + q;
            const f32x4 x0 = xq[q][0], x1 = xq[q][1], x2 = xq[q][2], x3 = xq[q][3];
            float xv[16] = {x0[0], x0[1], x0[2], x0[3], x1[0], x1[1], x1[2], x1[3], x2[0], x2[1], x2[2], x2[3], x3[0], x3[1], x3[2], x3[3]};
            float ss = 0.f;
#pragma unroll
            for (int i = 0; i < 16; ++i) ss += xv[i] * xv[i];
            ss = wave_sum(ss);
            const float rstd = rsqrtf(ss * (1.0f / DM) + EPS);
            float h[16];
#pragma unroll
            for (int i = 0; i < 16; ++i) h[i] = xv[i] * rstd * cs[i] + sh[i];
            u32x4 w0, w1;
            w0.x = pack2(h[0], h[1]); w0.y = pack2(h[2], h[3]); w0.z = pack2(h[4], h[5]); w0.w = pack2(h[6], h[7]);
            w1.x = pack2(h[8], h[9]); w1.y = pack2(h[10], h[11]); w1.z = pack2(h[12], h[13]); w1.w = pack2(h[14], h[15]);
            bf16_t* hp = hout + (size_t)row * DM + lane * 8;
            *(u32x4*)hp = w0; *(u32x4*)(hp + 512) = w1;
            if (wsc) {
                float mine = 0.f;
#pragma unroll
                for (int j = 0; j < 12; ++j) {
                    const float* wj = wl + j * DM + lane * 8;
                    const f32x4 a0 = *(const f32x4*)wj, a1 = *(const f32x4*)(wj + 4), a2 = *(const f32x4*)(wj + 512), a3 = *(const f32x4*)(wj + 516);
                    float s = h[0] * a0[0] + h[1] * a0[1] + h[2] * a0[2] + h[3] * a0[3] + h[4] * a1[0] + h[5] * a1[1] + h[6] * a1[2] + h[7] * a1[3]
                            + h[8] * a2[0] + h[9] * a2[1] + h[10] * a2[2] + h[11] * a2[3] + h[12] * a3[0] + h[13] * a3[1] + h[14] * a3[2] + h[15] * a3[3];
                    s = wave_sum(s);
                    mine = (lane == j) ? s : mine;
                }
                if (lane < 12) scal[(size_t)row * 16 + lane] = mine;
            }
            }
        }
    }
}

__device__ void phase_final_norm(const float* xin, const float* g, float* out) {
    const int tid = my_tid(), wid = tid >> 6, lane = tid & 63;
    const int gw = my_bid() * 8 + wid, nw = my_gdim() * 8;
    f32x4 gv[4];
#pragma unroll
    for (int i = 0; i < 4; ++i) gv[i] = *(const f32x4*)(g + i * 256 + lane * 4);
    for (int rb = gw * 4; rb < MTOK; rb += nw * 4) {
        f32x4 x[4][4];
#pragma unroll
        for (int q = 0; q < 4; ++q)
#pragma unroll
            for (int i = 0; i < 4; ++i) x[q][i] = __builtin_nontemporal_load((const f32x4*)(xin + (size_t)(rb + q) * DM + i * 256 + lane * 4));
#pragma unroll
        for (int q = 0; q < 4; ++q) { float ss = 0.f;
#pragma unroll
            for (int i = 0; i < 4; ++i) ss += (x[q][i][0] * x[q][i][0] + x[q][i][1] * x[q][i][1]) + (x[q][i][2] * x[q][i][2] + x[q][i][3] * x[q][i][3]);
            ss = wave_sum(ss);
            const float rstd = rsqrtf(ss * (1.0f / DM) + EPS);
#pragma unroll
            for (int i = 0; i < 4; ++i) __builtin_nontemporal_store(x[q][i] * rstd * gv[i], (f32x4*)(out + (size_t)(rb + q) * DM + i * 256 + lane * 4)); }
    }
}

__device__ void phase_finalize(const unsigned char* __restrict__ prep, const bf16_t* __restrict__ pz, const float* gn, bf16_t* __restrict__ mix) {
    const int tid = my_tid(), wid = tid >> 6, lane = tid & 63;
    const int gw = my_bid() * 8 + wid, nw = my_gdim() * 8;
    const int hh = lane >> 4, d0 = (lane & 15) * 8;
    float gv[8];
#pragma unroll
    for (int j = 0; j < 8; ++j) gv[j] = gn[d0 + j];
    for (int rb = gw * 4; rb < MTOK; rb += nw * 4) {
        u32x4 oq[4], zq[4];
#pragma unroll
        for (int q = 0; q < 4; ++q) { const int row = rb + q, b = row >> 13, t = row & (SEQ - 1), n = t >> 6, c = t & 63;
            oq[q] = __builtin_nontemporal_load((const u32x4*)(prep + (size_t)(((b * 4 + hh) * 128) + n) * PREP_UNIT + 57344 + (d0 >> 6) * 8192 + (c * 64 + (d0 & 63)) * 2));
            zq[q] = __builtin_nontemporal_load((const u32x4*)(pz + (size_t)row * 512 + lane * 8)); }
#pragma unroll
        for (int q = 0; q < 4; ++q) { const int row = rb + q;
            float ov[8]; unpack8(oq[q], ov);
            float ss = 0.f;
#pragma unroll
            for (int j = 0; j < 8; ++j) ss += ov[j] * ov[j];
            ss += __shfl_xor(ss, 1); ss += __shfl_xor(ss, 2); ss += __shfl_xor(ss, 4); ss += __shfl_xor(ss, 8);
            const float rstd = rsqrtf(ss * (1.0f / 128.0f) + EPS);
            float zf[8]; unpack8(zq[q], zf);
            float r[8];
#pragma unroll
            for (int j = 0; j < 8; ++j) r[j] = ov[j] * rstd * gv[j] * silu_f(zf[j]);
            u32x4 w; w.x = pack2(r[0], r[1]); w.y = pack2(r[2], r[3]); w.z = pack2(r[4], r[5]); w.w = pack2(r[6], r[7]);
            *(u32x4*)(mix + (size_t)row * DM + 512 + lane * 8) = w; }
    }
}

__device__ void phase_fixup(const float* halo, const float* cw  , bf16_t* act) {
    const int gt = my_bid() * NTHR + my_tid(), stride = my_gdim() * NTHR;
    for (int task = gt; task < 128 * 22 * 16; task += stride) {
        const int c = (task & 15) * 8, pn = (task >> 4) % 22, pm = (task >> 4) / 22, j = pn * 128 + c;
        const float* ht = halo + (size_t)(pm * 22 + pn) * 1024 + c;
        const bool first = ((pm * 256) & (SEQ - 1)) == 0;
        const float* hp = halo + (size_t)((first ? pm : pm - 1) * 22 + pn) * 1024 + c;
        float a0[8], a1[8];
#pragma unroll
        for (int q = 0; q < 2; ++q) {
            const f32x4 z4 = (f32x4){0.f, 0.f, 0.f, 0.f};
            const f32x4 g0 = *(const f32x4*)(ht + 4 * q), g1 = *(const f32x4*)(ht + 256 + 4 * q), u0 = *(const f32x4*)(ht + 128 + 4 * q), u1 = *(const f32x4*)(ht + 384 + 4 * q);
            const f32x4 gb0 = first ? z4 : *(const f32x4*)(hp + 512 + 4 * q), gb1 = first ? z4 : *(const f32x4*)(hp + 768 + 4 * q);
            const f32x4 ub0 = first ? z4 : *(const f32x4*)(hp + 640 + 4 * q), ub1 = first ? z4 : *(const f32x4*)(hp + 896 + 4 * q);
            const f32x4 wg0 = *(const f32x4*)(cw + j + 4 * q), wg1 = *(const f32x4*)(cw + NUP + j + 4 * q), wg2 = *(const f32x4*)(cw + 2 * NUP + j + 4 * q);
            const f32x4 wu0 = *(const f32x4*)(cw + DFF + j + 4 * q), wu1 = *(const f32x4*)(cw + NUP + DFF + j + 4 * q), wu2 = *(const f32x4*)(cw + 2 * NUP + DFF + j + 4 * q);
#pragma unroll
            for (int e = 0; e < 4; ++e) {
                a0[4 * q + e] = silu_f(wg0[e] * gb0[e] + wg1[e] * gb1[e] + wg2[e] * g0[e]) * (wu0[e] * ub0[e] + wu1[e] * ub1[e] + wu2[e] * u0[e]);
                a1[4 * q + e] = silu_f(wg0[e] * gb1[e] + wg1[e] * g0[e] + wg2[e] * g1[e]) * (wu0[e] * ub1[e] + wu1[e] * u0[e] + wu2[e] * u1[e]); }
        }
        u32x4 w0, w1;
        w0.x = pack2(a0[0], a0[1]); w0.y = pack2(a0[2], a0[3]); w0.z = pack2(a0[4], a0[5]); w0.w = pack2(a0[6], a0[7]);
        w1.x = pack2(a1[0], a1[1]); w1.y = pack2(a1[2], a1[3]); w1.z = pack2(a1[4], a1[5]); w1.w = pack2(a1[6], a1[7]);
        *(u32x4*)(act + (size_t)(pm * 256) * DFF + j) = w0;
        *(u32x4*)(act + (size_t)(pm * 256 + 1) * DFF + j) = w1;
    }
}

__device__ void fcum_unit(unsigned char* lds, int bh, const float* scal, const float* fgb  , float* F, const bf16_t* kp  , float* knsuf  , const bf16_t* kpa  , const float* relh  , float* ab  , unsigned* flag, unsigned fval) {
    const int tid = my_tid(), wid = tid >> 6, lane = tid & 63, b = bh >> 2, h = bh & 3;
    float* wt = (float*)lds;
    const float fb = fgb[h];
    float v[16]; float run = 0.f;
#pragma unroll
    for (int i = 0; i < 16; ++i) { const float x = scal[((size_t)b * SEQ + tid * 16 + i) * 16 + h] + fb; run += fminf(x, 0.f) - log1pf(__expf(-fabsf(x))); v[i] = run; }
    float inc = run;
#pragma unroll
    for (int o = 1; o < 64; o <<= 1) { const float y = __shfl_up(inc, o); if (lane >= o) inc += y; }
    if (lane == 63) wt[wid] = inc;
    __syncthreads();
    float off = inc - run;
    for (int w = 0; w < wid; ++w) off += wt[w];
#pragma unroll
    for (int i = 0; i < 16; ++i) F[(size_t)bh * SEQ + tid * 16 + i] = v[i] + off;
    float* km = (float*)(lds + 1024);
    for (int t = wid; t < 128; t += 8) {
        const bf16_t* kr = kp + (size_t)(t * 64 + lane) * 1536; float ss = 0.f;
#pragma unroll
        for (int q = 0; q < 8; ++q) { float f[8]; unpack8(*(const u32x4*)(kr + 8 * q), f);
#pragma unroll
            for (int j = 0; j < 8; ++j) ss += f[j] * f[j]; }
        float m = sqrtf(ss);
#pragma unroll
        for (int o = 32; o > 0; o >>= 1) m = fmaxf(m, __shfl_xor(m, o));
        if (lane == 0) km[t] = m;
    }
    __syncthreads();
    if (tid < 128) { float m = 0.f; for (int t = 0; t <= tid; ++t) m = fmaxf(m, km[t]); knsuf[tid] = m; }
    { float* km2 = (float*)(lds + 2048); float mw = 0.f;
      for (int t = wid; t < 128; t += 8) {
          const bf16_t* kr = kpa + (size_t)(t * 64 + lane) * 1536; float ss = 0.f;
#pragma unroll
          for (int q = 0; q < 8; ++q) { float f[8]; unpack8(*(const u32x4*)(kr + 8 * q), f);
#pragma unroll
              for (int j = 0; j < 8; ++j) ss += f[j] * f[j]; }
          mw = fmaxf(mw, sqrtf(ss)); }
#pragma unroll
      for (int o = 32; o > 0; o >>= 1) mw = fmaxf(mw, __shfl_xor(mw, o));
      float bm = -1e30f;
      for (int i = tid; i < 320; i += NTHR) bm = fmaxf(bm, relh[i] * LOG2E);
#pragma unroll
      for (int o = 32; o > 0; o >>= 1) bm = fmaxf(bm, __shfl_xor(bm, o));
      if (lane == 0) { km2[wid] = mw; km2[8 + wid] = bm; }
      __syncthreads();
      if (tid == 0) { float a = 0.f, c = -1e30f; for (int w = 0; w < 8; ++w) { a = fmaxf(a, km2[w]); c = fmaxf(c, km2[8 + w]); } ab[0] = a * 1.0001f; ab[1] = c; }
    }
    handoff_publish(flag, fval);
    __syncthreads();
}

__device__ __forceinline__ void split_bf16(const float* x, bf16x8& hi, bf16x8& lo) {
    u32x4 h, l;
#pragma unroll
    for (int i = 0; i < 4; ++i) {
        const unsigned ph = pack2(x[2 * i], x[2 * i + 1]);
        const float r0 = x[2 * i] - __uint_as_float(ph << 16), r1 = x[2 * i + 1] - __uint_as_float(ph & 0xffff0000u);
        h[i] = ph; l[i] = pack2(r0, r1);
    }
    hi = __builtin_bit_cast(bf16x8, h); lo = __builtin_bit_cast(bf16x8, l);
}
__device__ void prep_unit(unsigned char* lds, int bh, int n, const bf16_t* pc, const float* scal, const float* convw  , float alog, float dtb, unsigned char* unit, float* egl, unsigned* flag, unsigned fval) {
    const int tid = my_tid(), wid = tid >> 6, lane = tid & 63, b = bh >> 2, h = bh & 3;
    float* qT = (float*)lds; float* kT = (float*)(lds + 34816); float* vT = (float*)(lds + 69632);
    float* Am = (float*)(lds + 104448); float* At = (float*)(lds + 121856);
    float* gc = (float*)(lds + 139264); float* bet = gc + 64; float* rq = gc + 128; float* rk = gc + 192;
    bf16_t* stage = (bf16_t*)(lds + 140288); float* ssp = (float*)(lds + 140288);
    const size_t row0 = (size_t)b * SEQ + (size_t)n * 64;
    const __amdgpu_buffer_rsrc_t ur = __builtin_amdgcn_make_buffer_rsrc(unit, 0, PREP_UNIT, 0x00020000);
#ifndef REP_S1
#define REP_S1 1
#endif
    for (int rep1 = 0; rep1 < REP_S1; ++rep1) {
    if (tid < 384) {
        const int part = tid >> 7, cg8 = (tid & 127) >> 3, run = tid & 7, col = part * 512 + h * 128 + cg8 * 8;
        float w[4][8];
#pragma unroll
        for (int i = 0; i < 4; ++i) { const f32x4 w0 = *(const f32x4*)(convw + i * 1536 + col), w1 = *(const f32x4*)(convw + i * 1536 + col + 4);
#pragma unroll
            for (int j = 0; j < 4; ++j) { w[i][j] = w0[j]; w[i][4 + j] = w1[j]; } }
        u32x4 xr[11];
#pragma unroll
        for (int i = 0; i < 11; ++i) { const int tl = run * 8 - 3 + i; const bool ok = (n > 0) || (tl >= 0);
            xr[i] = ok ? __builtin_nontemporal_load((const u32x4*)(pc + (row0 + tl) * 1536 + col)) : (u32x4){0u, 0u, 0u, 0u}; }
        float y[8][8];
#pragma unroll
        for (int t = 0; t < 8; ++t)
#pragma unroll
            for (int j = 0; j < 8; ++j) y[t][j] = 0.f;
#pragma unroll
        for (int i = 0; i < 11; ++i) { float xf[8]; unpack8(xr[i], xf);
#pragma unroll
            for (int t = 0; t < 8; ++t) { const int wi = i - t; if (wi >= 0 && wi < 4) {
#pragma unroll
                for (int j = 0; j < 8; ++j) y[t][j] += w[wi][j] * xf[j]; } } }
        float* XT = part == 0 ? qT : (part == 1 ? kT : vT);
        float sq[8];
#pragma unroll
        for (int t = 0; t < 8; ++t) sq[t] = 0.f;
#pragma unroll
        for (int j = 0; j < 8; ++j) {
#pragma unroll
            for (int t = 0; t < 8; ++t) { y[t][j] = silu_f(y[t][j]); sq[t] += y[t][j] * y[t][j]; }
            f32x4 a, c;
            a[0] = y[0][j]; a[1] = y[1][j]; a[2] = y[2][j]; a[3] = y[3][j]; c[0] = y[4][j]; c[1] = y[5][j]; c[2] = y[6][j]; c[3] = y[7][j];
            *(f32x4*)(XT + (cg8 * 8 + j) * 68 + run * 8) = a; *(f32x4*)(XT + (cg8 * 8 + j) * 68 + run * 8 + 4) = c;
        }
        if (part < 2) {
#pragma unroll
            for (int t = 0; t < 8; ++t) { float v = sq[t]; v += __shfl_xor(v, 8); v += __shfl_xor(v, 16); v += __shfl_xor(v, 32); sq[t] = v; }
            if ((lane >> 3) == 0) {
#pragma unroll
                for (int t = 0; t < 8; ++t) ssp[(part * 2 + (wid & 1)) * 64 + run * 8 + t] = sq[t];
            }
        }
    } else if (tid < 448) {
        const int t = tid - 384; const float* sp = scal + (row0 + t) * 16;
        bet[t] = 1.0f / (1.0f + __expf(-sp[4 + h]));
        gc[t] = -__expf(alog) * softplus_f(sp[8 + h] + dtb);
    }
    __syncthreads();
    }
    if (tid < 64) rq[tid] = rsqrtf(ssp[tid] + ssp[64 + tid] + EPS) * 0.08838834764831845f;
    else if (tid < 128) rk[tid - 64] = rsqrtf(ssp[128 + tid - 64] + ssp[192 + tid - 64] + EPS);
    else if (tid < 192) { float v = gc[lane];
#pragma unroll
        for (int o = 1; o < 64; o <<= 1) { const float y = __shfl_up(v, o); if (lane >= o) v += y; }
        gc[lane] = v; }
    __syncthreads();
#ifndef REP_S3
#define REP_S3 1
#endif
    for (int rep3 = 0; rep3 < REP_S3; ++rep3) {
    {
        const int rb = wid & 3, quad = lane >> 4, cl = lane & 15; const bool isq = wid >= 4;
        const float* XT = isq ? qT : kT; float* Out = isq ? At : Am; const float* rX = isq ? rq : rk;
        bf16x8 ah[4], al[4];
#pragma unroll
        for (int ks = 0; ks < 4; ++ks) { float x[8];
#pragma unroll
            for (int jj = 0; jj < 8; ++jj) x[jj] = XT[(32 * ks + 16 * (jj >> 2) + 4 * quad + (jj & 3)) * 68 + 16 * rb + cl];
            split_bf16(x, ah[ks], al[ks]); }
        float gi[4], si[4];
#pragma unroll
        for (int j = 0; j < 4; ++j) { const int i = 16 * rb + quad * 4 + j; gi[j] = gc[i]; si[j] = rX[i] * (isq ? 1.0f : bet[i]); }
        for (int cb = 0; cb < 4; ++cb) {
            const int jc = 16 * cb + cl;
            if (cb <= rb) {
                f32x4 acc = (f32x4){0.f, 0.f, 0.f, 0.f};
#pragma unroll
                for (int ks = 0; ks < 4; ++ks) { float x[8]; bf16x8 bh_, bl_;
#pragma unroll
                    for (int jj = 0; jj < 8; ++jj) x[jj] = kT[(32 * ks + 16 * (jj >> 2) + 4 * quad + (jj & 3)) * 68 + jc];
                    split_bf16(x, bh_, bl_);
                    acc = MFMA16(ah[ks], bh_, acc); acc = MFMA16(ah[ks], bl_, acc); acc = MFMA16(al[ks], bh_, acc); }
                const float gj = gc[jc], sj = rk[jc];
#pragma unroll
                for (int j = 0; j < 4; ++j) { const int i = 16 * rb + quad * 4 + j; const bool keep = isq ? (i >= jc) : (i > jc);
                    Out[i * 68 + jc] = keep ? acc[j] * si[j] * sj * __expf(fminf(gi[j] - gj, 0.f)) : 0.f; }
            } else {
#pragma unroll
                for (int j = 0; j < 4; ++j) Out[(16 * rb + quad * 4 + j) * 68 + jc] = 0.f;
            }
        }
    }
    __syncthreads();
    }
    if (wid == 0) {
        const int c = lane;
        int zv = 0; asm volatile("" : "+v"(zv)); const float* AmV = Am + zv;
        for (int rb = 0; rb < 4; ++rb) {
            typedef float f32x2v __attribute__((ext_vector_type(2)));
            f32x2v sp[8];
#pragma unroll
            for (int q = 0; q < 8; ++q) { sp[q][0] = (16 * rb + 2 * q == c) ? 1.0f : 0.0f; sp[q][1] = (16 * rb + 2 * q + 1 == c) ? 1.0f : 0.0f; }
            for (int j4 = 0; j4 < 4 * rb; ++j4) {
                const float t0 = Am[(4 * j4 + 0) * 68 + c], t1 = Am[(4 * j4 + 1) * 68 + c], t2 = Am[(4 * j4 + 2) * 68 + c], t3 = Am[(4 * j4 + 3) * 68 + c];
                const f32x2v T0 = {t0, t0}, T1 = {t1, t1}, T2 = {t2, t2}, T3 = {t3, t3};
#pragma unroll
                for (int q = 0; q < 8; ++q) { const f32x4 a4 = *(const f32x4*)(AmV + (16 * rb + 2 * q) * 68 + 4 * j4), b4 = *(const f32x4*)(AmV + (16 * rb + 2 * q + 1) * 68 + 4 * j4);
                    f32x2v acc2 = sp[q];
                    acc2 -= (f32x2v){a4[0], b4[0]} * T0; acc2 -= (f32x2v){a4[1], b4[1]} * T1; acc2 -= (f32x2v){a4[2], b4[2]} * T2; acc2 -= (f32x2v){a4[3], b4[3]} * T3;
                    sp[q] = acc2; }
            }
            float sx[16];
#pragma unroll
            for (int r = 0; r < 16; ++r) sx[r] = sp[r >> 1][r & 1];
#pragma unroll
            for (int r = 1; r < 16; ++r) {
#pragma unroll
                for (int q4 = 0; q4 < (r + 3) / 4; ++q4) { const f32x4 a4 = *(const f32x4*)(AmV + (16 * rb + r) * 68 + 16 * rb + 4 * q4);
#pragma unroll
                    for (int jj = 0; jj < 4; ++jj) if (4 * q4 + jj < r) sx[r] -= a4[jj] * sx[4 * q4 + jj]; }
            }
            bf16_t* sf = stage + (rb * 2 + (c >> 5)) * 512 + ((c >> 3) & 3) * 128 + (c & 7);
#pragma unroll
            for (int r = 0; r < 16; r += 2) {
                Am[(16 * rb + r) * 68 + c] = sx[r]; Am[(16 * rb + r + 1) * 68 + c] = sx[r + 1];
                const unsigned ph = pack2(sx[r], sx[r + 1]);
                const unsigned pl = pack2(sx[r] - __uint_as_float(ph << 16), sx[r + 1] - __uint_as_float(ph & 0xffff0000u));
                sf[r * 8] = (bf16_t)(ph & 0xffffu); sf[(r + 1) * 8] = (bf16_t)(ph >> 16);
                sf[4096 + r * 8] = (bf16_t)(pl & 0xffffu); sf[4096 + (r + 1) * 8] = (bf16_t)(pl >> 16);
            }
        }
    } else if (tid >= 256) {
        const int u = tid - 256; const float glast = gc[63];
#pragma unroll
        for (int it = 0; it < 4; ++it) {
            const int q = u + 256 * it, f = q >> 6, L = q & 63, mt = f >> 2, ks = f & 3, quad = L >> 4, r = L & 15, i_ = 16 * mt + r;
            const float eg = __expf(gc[i_]) * rq[i_]; float v[8];
#pragma unroll
            for (int jj = 0; jj < 8; ++jj) { const int kd = 32 * ks + 16 * (jj >> 2) + 4 * quad + (jj & 3); v[jj] = qT[kd * 68 + i_] * eg; }
            u32x4 w; w.x = pack2(v[0], v[1]); w.y = pack2(v[2], v[3]); w.z = pack2(v[4], v[5]); w.w = pack2(v[6], v[7]);
            __builtin_amdgcn_raw_buffer_store_b128(w, ur, 16384 + q * 16, 0, 16);
        }
#pragma unroll
        for (int it = 0; it < 4; ++it) {
            const int q = u + 256 * it, f = q >> 6, L = q & 63, mt = f >> 1, ks = f & 1, quad = L >> 4, r = L & 15, kd = 16 * mt + r;
            float v[8];
#pragma unroll
            for (int hh = 0; hh < 2; ++hh) { const int c0 = 32 * ks + 16 * hh + 4 * quad; const f32x4 kk = *(const f32x4*)(kT + kd * 68 + c0), gg = *(const f32x4*)(gc + c0), rr = *(const f32x4*)(rk + c0);
#pragma unroll
                for (int j = 0; j < 4; ++j) v[hh * 4 + j] = kk[j] * rr[j] * __expf(glast - gg[j]); }
            u32x4 w; w.x = pack2(v[0], v[1]); w.y = pack2(v[2], v[3]); w.z = pack2(v[4], v[5]); w.w = pack2(v[6], v[7]);
            __builtin_amdgcn_raw_buffer_store_b128(w, ur, 32768 + q * 16, 0, 16);
        }
#pragma unroll
        for (int it = 0; it < 2; ++it) {
            const int q = u + 256 * it, f = q >> 6, L = q & 63, mt = f >> 1, ks = f & 1, quad = L >> 4, r = L & 15, i_ = 16 * mt + r;
            const f32x4 a0 = *(const f32x4*)(At + i_ * 68 + 32 * ks + 4 * quad), a1 = *(const f32x4*)(At + i_ * 68 + 32 * ks + 16 + 4 * quad);
            u32x4 w; w.x = pack2(a0[0], a0[1]); w.y = pack2(a0[2], a0[3]); w.z = pack2(a1[0], a1[1]); w.w = pack2(a1[2], a1[3]);
            __builtin_amdgcn_raw_buffer_store_b128(w, ur, 49152 + q * 16, 0, 16);
        }
        if (u == 0) __hip_atomic_store(egl + bh * 128 + n, __expf(glast), __ATOMIC_RELAXED, __HIP_MEMORY_SCOPE_AGENT);
    }
    __syncthreads();
    f32x4 uw[2][4];
    {
        const int quad = lane >> 4, cl = lane & 15;
        bf16x8 th[4][2], tl[4][2];
#pragma unroll
        for (int mt = 0; mt < 4; ++mt)
#pragma unroll
            for (int ks = 0; ks < 2; ++ks) { th[mt][ks] = *(const bf16x8*)((const unsigned char*)stage + ((mt * 2 + ks) * 512 + lane * 8) * 2); tl[mt][ks] = *(const bf16x8*)((const unsigned char*)stage + 8192 + ((mt * 2 + ks) * 512 + lane * 8) * 2); }
#pragma unroll
        for (int nt = 0; nt < 2; ++nt) {
            const int col = 32 * wid + 16 * nt + cl; const float* src = col < 128 ? vT + col * 68 : kT + (col - 128) * 68;
            bf16x8 bh_[2], bl_[2];
#pragma unroll
            for (int ks = 0; ks < 2; ++ks) { const int s0 = 32 * ks + quad * 8; float x[8];
                const f32x4 r0 = *(const f32x4*)(src + s0), r1 = *(const f32x4*)(src + s0 + 4), b0 = *(const f32x4*)(bet + s0), b1 = *(const f32x4*)(bet + s0 + 4);
#pragma unroll
                for (int j = 0; j < 4; ++j) { x[j] = r0[j] * b0[j]; x[4 + j] = r1[j] * b1[j]; }
                if (col >= 128) {
#pragma unroll
                    for (int j = 0; j < 8; ++j) x[j] *= rk[s0 + j] * __expf(gc[s0 + j]); }
                split_bf16(x, bh_[ks], bl_[ks]); }
#pragma unroll
            for (int mt = 0; mt < 4; ++mt) { f32x4 acc = (f32x4){0.f, 0.f, 0.f, 0.f};
#pragma unroll
                for (int ks = 0; ks < 2; ++ks) { acc = MFMA16(th[mt][ks], bh_[ks], acc); acc = MFMA16(tl[mt][ks], bh_[ks], acc); acc = MFMA16(th[mt][ks], bl_[ks], acc); }
                uw[nt][mt] = acc; }
        }
        if (wid < 4) {
#pragma unroll
            for (int nt = 0; nt < 2; ++nt)
#pragma unroll
                for (int mt = 0; mt < 4; ++mt) { u32x2 w; w.x = pack2(uw[nt][mt][0], uw[nt][mt][1]); w.y = pack2(uw[nt][mt][2], uw[nt][mt][3]);
                    __builtin_amdgcn_raw_buffer_store_b64(w, ur, 57344 + ((32 * wid + 16 * nt + cl) * 64 + 16 * mt + quad * 4) * 2, 0, 16); }
        }
    }
    __syncthreads();
    if (wid >= 4) {
        const int quad = lane >> 4, cl = lane & 15;
#pragma unroll
        for (int nt = 0; nt < 2; ++nt) { const int kd = 32 * (wid - 4) + 16 * nt + cl, ks = kd >> 5, kd32 = kd & 31, fo = ks * 512 + ((kd32 >> 2) & 3) * 128 + (kd32 >> 4) * 4 + (kd32 & 3);
#pragma unroll
            for (int mt = 0; mt < 4; ++mt) {
                const unsigned p0 = pack2(-uw[nt][mt][0], -uw[nt][mt][1]), p1 = pack2(-uw[nt][mt][2], -uw[nt][mt][3]);
                const int ob = mt * 2048 + fo + (quad * 4) * 8;
                stage[ob] = (bf16_t)(p0 & 0xffffu); stage[ob + 8] = (bf16_t)(p0 >> 16); stage[ob + 16] = (bf16_t)(p1 & 0xffffu); stage[ob + 24] = (bf16_t)(p1 >> 16);
            } }
    }
    __syncthreads();
#pragma unroll
    for (int it = 0; it < 2; ++it) { const int q = tid + NTHR * it; __builtin_amdgcn_raw_buffer_store_b128(*(const u32x4*)((const unsigned char*)stage + q * 16), ur, q * 16, 0, 16); }
    handoff_publish_wt(flag, fval);
}

__device__ __forceinline__ int scan_wait(unsigned char* lds, const unsigned* uflag, int ready, int need, unsigned fval) {
    volatile int* slot = (volatile int*)(lds + LDS_SLOT_C + 4);
    if (threadIdx.x < 64) {
        const int lane = threadIdx.x; int r = ready;
        for (;;) {
            const int idx = r + lane; unsigned v = fval;
            if (idx < 128) v = __hip_atomic_load(uflag + idx, __ATOMIC_RELAXED, __HIP_MEMORY_SCOPE_AGENT);
            const unsigned long long notready = __ballot(v < fval);
            const int cnt = notready ? (int)__builtin_ctzll(notready) : 64;
            r += cnt; if (r > 128) r = 128;
            if (r >= need) break;
            __builtin_amdgcn_s_sleep(8);
        }
        __builtin_amdgcn_fence(__ATOMIC_ACQUIRE, "agent");
        asm volatile("s_waitcnt vmcnt(0)" ::: "memory");
        if (lane == 0) *slot = r;
    }
    __syncthreads();
    const int res = *slot;
    __syncthreads();
    return res;
}
#define SCAN_SB __builtin_amdgcn_sched_barrier(0)
__device__ __forceinline__ void scan_compute(const unsigned char* B, const u32x2* ut, float eg, f32x4* Sacc, bf16x8* Sb, bf16_t* op0, int lane) {
    const unsigned char* Bl = B + lane * 16;
    bf16x8 fx[16], fy[8];
#pragma unroll
    for (int i = 0; i < 16; ++i) fx[i] = *(const bf16x8*)(Bl + i * 1024);
#pragma unroll
    for (int i = 0; i < 8; ++i) fy[i] = *(const bf16x8*)(Bl + 16384 + i * 1024);
    f32x4 vn[4];
#pragma unroll
    for (int mt = 0; mt < 4; ++mt) { vn[mt][0] = __uint_as_float(ut[mt].x << 16); vn[mt][1] = __uint_as_float(ut[mt].x & 0xffff0000u); vn[mt][2] = __uint_as_float(ut[mt].y << 16); vn[mt][3] = __uint_as_float(ut[mt].y & 0xffff0000u); }
    SCAN_SB;
#pragma unroll
    for (int ks = 0; ks < 4; ++ks)
#pragma unroll
        for (int mt = 0; mt < 4; ++mt) vn[mt] = MFMA16(fx[mt * 4 + ks], Sb[ks], vn[mt]);
    SCAN_SB;
#pragma unroll
    for (int i = 0; i < 8; ++i) fx[i] = *(const bf16x8*)(Bl + 16384 + (8 + i) * 1024);
#pragma unroll
    for (int i = 0; i < 8; ++i) fx[8 + i] = *(const bf16x8*)(Bl + 49152 + i * 1024);
    f32x4 oa[4];
#pragma unroll
    for (int mt = 0; mt < 4; ++mt) oa[mt] = (f32x4){0.f, 0.f, 0.f, 0.f};
    SCAN_SB;
#pragma unroll
    for (int ks = 0; ks < 4; ++ks)
#pragma unroll
        for (int mt = 0; mt < 2; ++mt) oa[mt] = MFMA16(fy[mt * 4 + ks], Sb[ks], oa[mt]);
    bf16x8 Vb[2];
#pragma unroll
    for (int ks = 0; ks < 2; ++ks) { u32x4 w; w.x = pack2(vn[2 * ks][0], vn[2 * ks][1]); w.y = pack2(vn[2 * ks][2], vn[2 * ks][3]); w.z = pack2(vn[2 * ks + 1][0], vn[2 * ks + 1][1]); w.w = pack2(vn[2 * ks + 1][2], vn[2 * ks + 1][3]);
        Vb[ks] = __builtin_bit_cast(bf16x8, w); }
    SCAN_SB;
#pragma unroll
    for (int i = 0; i < 8; ++i) fy[i] = *(const bf16x8*)(Bl + 32768 + i * 1024);
    SCAN_SB;
#pragma unroll
    for (int ks = 0; ks < 4; ++ks)
#pragma unroll
        for (int mt = 2; mt < 4; ++mt) oa[mt] = MFMA16(fx[(mt - 2) * 4 + ks], Sb[ks], oa[mt]);
#pragma unroll
    for (int ks = 0; ks < 2; ++ks)
#pragma unroll
        for (int mt = 0; mt < 4; ++mt) oa[mt] = MFMA16(fx[8 + mt * 2 + ks], Vb[ks], oa[mt]);
    SCAN_SB;
#pragma unroll
    for (int i = 0; i < 8; ++i) fx[i] = *(const bf16x8*)(Bl + 32768 + (8 + i) * 1024);
    SCAN_SB;
#pragma unroll
    for (int m8 = 0; m8 < 4; ++m8) { f32x4 acc = Sacc[m8] * eg;
#pragma unroll
        for (int ks = 0; ks < 2; ++ks) acc = MFMA16(fy[m8 * 2 + ks], Vb[ks], acc);
        Sacc[m8] = acc; }
    SCAN_SB;
#pragma unroll
    for (int m8 = 4; m8 < 8; ++m8) { f32x4 acc = Sacc[m8] * eg;
#pragma unroll
        for (int ks = 0; ks < 2; ++ks) acc = MFMA16(fx[(m8 - 4) * 2 + ks], Vb[ks], acc);
        Sacc[m8] = acc; }
#pragma unroll
    for (int mt = 0; mt < 4; ++mt) {
        bf16_t* op = op0 + (16 * mt) * 64;
        const unsigned p0 = pack2(oa[mt][0], oa[mt][1]), p1 = pack2(oa[mt][2], oa[mt][3]);
        op[0] = (bf16_t)(p0 & 0xffffu); op[64] = (bf16_t)(p0 >> 16); op[128] = (bf16_t)(p1 & 0xffffu); op[192] = (bf16_t)(p1 >> 16);
    }
#pragma unroll
    for (int ks = 0; ks < 4; ++ks) { u32x4 w; w.x = pack2(Sacc[2 * ks][0], Sacc[2 * ks][1]); w.y = pack2(Sacc[2 * ks][2], Sacc[2 * ks][3]); w.z = pack2(Sacc[2 * ks + 1][0], Sacc[2 * ks + 1][1]); w.w = pack2(Sacc[2 * ks + 1][2], Sacc[2 * ks + 1][3]);
        Sb[ks] = __builtin_bit_cast(bf16x8, w); }
}
#undef SCAN_SB

__device__ void scan_unit(unsigned char* lds, int bh, int half, unsigned char* prep, const float* egl, const unsigned* uflag  , unsigned fval) {
    const int tid = my_tid(), lane = tid & 63, b = bh >> 2, h = bh & 3, quad = lane >> 4, cl = lane & 15;
    const int wid = __builtin_amdgcn_readfirstlane(tid >> 6);
    unsigned char* ubase = prep + (size_t)bh * 128 * PREP_UNIT;
    int ready = 0;
    (void)b; (void)h;
#define SCAN_BAR() asm volatile("s_waitcnt lgkmcnt(0)\n\ts_barrier" ::: "memory")
#define SCAN_WAIT(c) do { if ((c) < 128 && ready < (c) + 1) ready = scan_wait(lds, uflag, ready, (c) + 1, fval); } while (0)
    if (wid >= 4) {
        const int lt = tid - 256;
        u32x4 r0[14], r1[14], r2[14];
#define LD_LOAD(R, c) do { SCAN_WAIT(c); if ((c) < 128) { const unsigned char* uc_ = ubase + (size_t)(c) * PREP_UNIT; \
            _Pragma("unroll") for (int i = 0; i < 14; ++i) R[i] = *(const u32x4*)(uc_ + (size_t)(lt + 256 * i) * 16); } } while (0)
#define LD_STORE(R, c) do { if ((c) < 128) { _Pragma("unroll") for (int i = 0; i < 14; ++i) *(u32x4*)(lds + ((c) & 1) * 57344 + (size_t)(lt + 256 * i) * 16) = R[i]; } } while (0)
#define LD_STEP(n, RL, RS) do { if ((n) < 128) { LD_LOAD(RL, (n) + 3); LD_STORE(RS, (n) + 1); SCAN_BAR(); } } while (0)
        LD_LOAD(r0, 0); LD_LOAD(r1, 1); LD_LOAD(r2, 2);
        LD_STORE(r0, 0);
        __syncthreads();
        for (int n = 0; n < 128; n += 3) { LD_STEP(n, r0, r1); LD_STEP(n + 1, r1, r2); LD_STEP(n + 2, r2, r0); }
#undef LD_LOAD
#undef LD_STORE
#undef LD_STEP
    } else {
        const int col0 = half * 64 + wid * 16;
        f32x4 Sacc[8]; bf16x8 Sb[4];
#pragma unroll
        for (int i = 0; i < 8; ++i) Sacc[i] = (f32x4){0.f, 0.f, 0.f, 0.f};
#pragma unroll
        for (int i = 0; i < 4; ++i) Sb[i] = (bf16x8){0, 0, 0, 0, 0, 0, 0, 0};
        u32x2 r0u[4], r1u[4], r2u[4]; float r0e = 0.f, r1e = 0.f, r2e = 0.f;
#pragma unroll
        for (int mt = 0; mt < 4; ++mt) { r0u[mt] = (u32x2){0u, 0u}; r1u[mt] = (u32x2){0u, 0u}; r2u[mt] = (u32x2){0u, 0u}; }
#define CP_LOAD(R, c) do { SCAN_WAIT(c); if ((c) < 128) { const unsigned char* uc_ = ubase + (size_t)(c) * PREP_UNIT; \
            _Pragma("unroll") for (int mt = 0; mt < 4; ++mt) R##u[mt] = *(const u32x2*)(uc_ + 57344 + ((size_t)(col0 + cl) * 64 + 16 * mt + quad * 4) * 2); R##e = egl[bh * 128 + (c)]; } } while (0)
#define CP_STEP(n, R) do { if ((n) < 128) { \
            u32x2 cu_[4]; _Pragma("unroll") for (int mt = 0; mt < 4; ++mt) cu_[mt] = R##u[mt]; const float ce_ = R##e; \
            CP_LOAD(R, (n) + 3); \
            scan_compute(lds + ((n) & 1) * 57344, cu_, ce_, Sacc, Sb, (bf16_t*)(ubase + (size_t)(n) * PREP_UNIT + 57344 + half * 8192) + (quad * 4) * 64 + wid * 16 + cl, lane); \
            SCAN_BAR(); } } while (0)
        CP_LOAD(r0, 0); CP_LOAD(r1, 1); CP_LOAD(r2, 2);
        __syncthreads();
        for (int n = 0; n < 128; n += 3) { CP_STEP(n, r0); CP_STEP(n + 1, r1); CP_STEP(n + 2, r2); }
#undef CP_LOAD
#undef CP_STEP
    }
#undef SCAN_WAIT
#undef SCAN_BAR
}

template <int MODE>
__device__ void attn_unit(unsigned char* lds, int b, int qb, const bf16_t* Qp, const bf16_t* Kp, const bf16_t* Vp, int ld, bf16_t* Op, int ldo, const float* Fbh, const float* reltab, const float* knsuf, const unsigned* fflag, unsigned fval) {
    const int tid = my_tid(), wid = tid >> 6, lane = tid & 63, quad = lane >> 4, cl = lane & 15;
    const size_t rowbase = (size_t)b * SEQ; const int q0 = qb * 256, qw0 = q0 + 32 * wid, cq = qw0 >> 6;
    float* fkb = (float*)(lds + 36864); float* ext = (float*)(lds + 37376);
    const int kt0 = MODE == 0 ? 0 : (q0 / 64 - 8 > 0 ? q0 / 64 - 8 : 0), kt1 = q0 / 64 + 3;
    handoff_wait_one(fflag, fval);
    const float Fref = MODE == 0 ? Fbh[q0] : 0.f;
    float* ktab = (float*)(lds + 40960); float* ftab = (float*)(lds + 41472); volatile int* flags = (volatile int*)(lds + 41984);
    const int nt = kt1 - kt0 + 1;
    if (MODE == 0) { for (int i = tid; i <= kt1; i += NTHR) { ktab[i] = knsuf[i]; ftab[i] = (Fref - Fbh[64 * i + 63]) * LOG2E; } }
    if (MODE == 1) { for (int i = tid; i < 640; i += NTHR) { int rel = 575 - i; rel = rel < -63 ? -63 : (rel > 256 ? 256 : rel); ext[i] = reltab[rel + 63] * LOG2E; } }
    bf16x8 qf[2][2];
#pragma unroll
    for (int nq = 0; nq < 2; ++nq)
#pragma unroll
        for (int ks = 0; ks < 2; ++ks) qf[nq][ks] = *(const bf16x8*)(Qp + (rowbase + qw0 + 16 * nq + cl) * ld + 32 * ks + quad * 8);
    float mrun[2] = {-1e30f, -1e30f}, lrun[2] = {0.f, 0.f};
    float qn[2] = {0.f, 0.f};
    {
#pragma unroll
        for (int nq = 0; nq < 2; ++nq) { float ss = 0.f;
#pragma unroll
            for (int ks = 0; ks < 2; ++ks)
#pragma unroll
                for (int j = 0; j < 8; ++j) { const float f = __uint_as_float(((unsigned)(unsigned short)qf[nq][ks][j]) << 16); ss += f * f; }
            ss += __shfl_xor(ss, 16); ss += __shfl_xor(ss, 32); qn[nq] = sqrtf(ss) * 1.0001f; }
    }
    bool done = false;
    float Rref[2] = {0.f, 0.f};
    if (MODE == 1) { const float ka = knsuf[0], bm = knsuf[1]; Rref[0] = qn[0] * ka + bm + 1.0f; Rref[1] = qn[1] * ka + bm + 1.0f; }
    else {
#pragma unroll
        for (int nq = 0; nq < 2; ++nq) { const int qrow = qw0 + 16 * nq + cl; Rref[nq] = qn[nq] * knsuf[qrow >> 6] + (Fref - Fbh[qrow]) * LOG2E + 1.0f; }
    }
    f32x4 o[4][2];
#pragma unroll
    for (int dt = 0; dt < 4; ++dt)
#pragma unroll
        for (int nq = 0; nq < 2; ++nq) o[dt][nq] = (f32x4){0.f, 0.f, 0.f, 0.f};
    const int skey = tid >> 3, sdch = tid & 7;
    const int vkey = tid & 63, vdch = tid >> 6;
    const int vpos = (vkey & 32) + ((vkey >> 2) & 3) * 8 + ((vkey >> 4) & 1) * 4 + (vkey & 3);
    u32x4 rk0, rv0, rk1, rv1, rk2, rv2; float rf0 = 0.f, rf1 = 0.f, rf2 = 0.f;
#define ATT_TILE(r) (MODE == 0 ? kt1 - (r) : kt0 + (r))
#define ATT_LOAD(S, r) do { if ((r) < nt) { const int t_ = ATT_TILE(r); rk##S = *(const u32x4*)(Kp + (rowbase + (size_t)t_ * 64 + skey) * ld + sdch * 8); rv##S = *(const u32x4*)(Vp + (rowbase + (size_t)t_ * 64 + vkey) * ld + vdch * 8); \
        if (MODE == 0 && tid < 64) rf##S = Fbh[t_ * 64 + tid]; } } while (0)
#define ATT_STORE(S, r) do { if ((r) < nt) { const int nb_ = (r) & 1; *(u32x4*)(lds + nb_ * 9216 + skey * 144 + sdch * 16) = rk##S; \
        bf16_t* vt_ = (bf16_t*)(lds + 18432 + nb_ * 9216); \
        _Pragma("unroll") for (int i = 0; i < 8; ++i) vt_[(vdch * 8 + i) * 72 + vpos] = (bf16_t)((rv##S[i >> 1] >> (16 * (i & 1))) & 0xffffu); \
        if (MODE == 0 && tid < 64) fkb[nb_ * 64 + tid] = (Fref - rf##S) * LOG2E; } } while (0)
    auto compute = [&](const int buf, const int kt) {
            const unsigned char* Kb = lds + buf * 9216; const unsigned char* Vb = lds + 18432 + buf * 9216;
            f32x4 s[2][4];
            bf16x8 kf[4][2];
#pragma unroll
            for (int mt = 0; mt < 4; ++mt) { kf[mt][0] = *(const bf16x8*)(Kb + (16 * mt + cl) * 144 + quad * 16); kf[mt][1] = *(const bf16x8*)(Kb + (16 * mt + cl) * 144 + 64 + quad * 16); }
#pragma unroll
            for (int mt = 0; mt < 4; ++mt)
#pragma unroll
                for (int nq = 0; nq < 2; ++nq) {
                    f32x4 c;
                    if (MODE == 0) { c = *(const f32x4*)(fkb + buf * 64 + 16 * mt + quad * 4); c = c - Rref[nq]; }
                    else { const int qi = (qw0 + 16 * nq + cl) & 63, idx0 = (kt - (cq - 8)) * 64 + 16 * mt + quad * 4 + 63 - qi; c[0] = ext[idx0] - Rref[nq]; c[1] = ext[idx0 + 1] - Rref[nq]; c[2] = ext[idx0 + 2] - Rref[nq]; c[3] = ext[idx0 + 3] - Rref[nq]; }
                    s[nq][mt] = c;
                }
            __builtin_amdgcn_sched_barrier(0);
#pragma unroll
            for (int mt = 0; mt < 4; ++mt)
#pragma unroll
                for (int nq = 0; nq < 2; ++nq) { s[nq][mt] = MFMA16(kf[mt][0], qf[nq][0], s[nq][mt]); s[nq][mt] = MFMA16(kf[mt][1], qf[nq][1], s[nq][mt]); }
            bf16x8 vf[4][2];
#pragma unroll
            for (int dt = 0; dt < 4; ++dt)
#pragma unroll
                for (int ks = 0; ks < 2; ++ks) vf[dt][ks] = *(const bf16x8*)(Vb + (16 * dt + cl) * 144 + ks * 64 + quad * 16);
            __builtin_amdgcn_sched_barrier(0);
            if (MODE == 0 && (64 * kt + 63 > qw0)) {
#pragma unroll
                for (int nq = 0; nq < 2; ++nq) { const int qrow = qw0 + 16 * nq + cl;
#pragma unroll
                    for (int mt = 0; mt < 4; ++mt)
#pragma unroll
                        for (int j = 0; j < 4; ++j) if (64 * kt + 16 * mt + quad * 4 + j > qrow) s[nq][mt][j] = -1e30f; }
            }
            bf16x8 pf[2][2];
#pragma unroll
            for (int nq = 0; nq < 2; ++nq) {
                if (true) {
                    float ps = 0.f;
#pragma unroll
                    for (int mt = 0; mt < 4; ++mt)
#pragma unroll
                        for (int j = 0; j < 4; ++j) { const float pv = __builtin_amdgcn_exp2f(s[nq][mt][j]); s[nq][mt][j] = pv; ps += pv; }
                    lrun[nq] += ps;
#pragma unroll
                    for (int ks = 0; ks < 2; ++ks) { u32x4 w; w.x = pack2(s[nq][2 * ks][0], s[nq][2 * ks][1]); w.y = pack2(s[nq][2 * ks][2], s[nq][2 * ks][3]); w.z = pack2(s[nq][2 * ks + 1][0], s[nq][2 * ks + 1][1]); w.w = pack2(s[nq][2 * ks + 1][2], s[nq][2 * ks + 1][3]);
                        pf[nq][ks] = __builtin_bit_cast(bf16x8, w); }
                    continue;
                }
                float mx = s[nq][0][0];
#pragma unroll
                for (int mt = 0; mt < 4; ++mt)
#pragma unroll
                    for (int j = 0; j < 4; ++j) mx = fmaxf(mx, s[nq][mt][j]);
                mx = fmaxf(mx, __shfl_xor(mx, 16)); mx = fmaxf(mx, __shfl_xor(mx, 32));
                const float mnew = fmaxf(mrun[nq], mx), alpha = __builtin_amdgcn_exp2f(mrun[nq] - mnew);
                mrun[nq] = mnew;
                float ps = 0.f;
#pragma unroll
                for (int mt = 0; mt < 4; ++mt)
#pragma unroll
                    for (int j = 0; j < 4; ++j) { const float pv = __builtin_amdgcn_exp2f(s[nq][mt][j] - mnew); s[nq][mt][j] = pv; ps += pv; }
                lrun[nq] = lrun[nq] * alpha + ps;
#pragma unroll
                for (int dt = 0; dt < 4; ++dt) o[dt][nq] = o[dt][nq] * alpha;
#pragma unroll
                for (int ks = 0; ks < 2; ++ks) { u32x4 w; w.x = pack2(s[nq][2 * ks][0], s[nq][2 * ks][1]); w.y = pack2(s[nq][2 * ks][2], s[nq][2 * ks][3]); w.z = pack2(s[nq][2 * ks + 1][0], s[nq][2 * ks + 1][1]); w.w = pack2(s[nq][2 * ks + 1][2], s[nq][2 * ks + 1][3]);
                    pf[nq][ks] = __builtin_bit_cast(bf16x8, w); }
            }
#pragma unroll
            for (int dt = 0; dt < 4; ++dt)
#pragma unroll
                for (int ks = 0; ks < 2; ++ks) { o[dt][0] = MFMA16(vf[dt][ks], pf[0][ks], o[dt][0]); o[dt][1] = MFMA16(vf[dt][ks], pf[1][ks], o[dt][1]); }
    };
#define ATT_STEP(r, SL, SS) do { if ((r) < nt && !done) { ATT_LOAD(SL, (r) + 3); const int kt_ = ATT_TILE(r); \
        const bool act_ = MODE == 0 ? (64 * kt_ <= qw0 + 31) : (kt_ >= cq - 8 && kt_ <= cq); \
        if (act_) compute((r) & 1, kt_); \
        if (MODE == 0) { bool c_ = true; if (kt_ >= 1) { const float kb_ = ktab[kt_ - 1], fb_ = ftab[kt_ - 1] + 1.0f; c_ = (qn[0] * kb_ + fb_ < Rref[0] - 152.0f) && (qn[1] * kb_ + fb_ < Rref[1] - 152.0f); } \
            const int v_ = __all(c_ ? 1 : 0); if (lane == 0) flags[((r) & 1) * 8 + wid] = v_; } \
        ATT_STORE(SS, (r) + 1); __syncthreads(); \
        if (MODE == 0) { int a_ = 1; _Pragma("unroll") for (int w_ = 0; w_ < 8; ++w_) a_ &= (flags[((r) & 1) * 8 + w_] != 0); done = (a_ != 0); } } } while (0)
    ATT_LOAD(0, 0); ATT_LOAD(1, 1); ATT_LOAD(2, 2);
    ATT_STORE(0, 0);
    __syncthreads();
    for (int r = 0; r < nt && !done; r += 3) {
        ATT_STEP(r, 0, 1);
        ATT_STEP(r + 1, 1, 2);
        ATT_STEP(r + 2, 2, 0);
    }
#undef ATT_TILE
#undef ATT_LOAD
#undef ATT_STORE
#undef ATT_STEP
#pragma unroll
    for (int nq = 0; nq < 2; ++nq) {
        float l = lrun[nq]; l += __shfl_xor(l, 16); l += __shfl_xor(l, 32);
        const float inv = 1.0f / l;
        bf16_t* op = Op + (rowbase + qw0 + 16 * nq + cl) * ldo + quad * 4;
#pragma unroll
        for (int dt = 0; dt < 4; ++dt) { u32x2 w; w.x = pack2(o[dt][nq][0] * inv, o[dt][nq][1] * inv); w.y = pack2(o[dt][nq][2] * inv, o[dt][nq][3] * inv); *(u32x2*)(op + 16 * dt) = w; }
    }
}

#ifndef REP_SCAN
#define REP_SCAN 1
#endif
#ifndef REP_A
#define REP_A 1
#endif
#ifndef REP_FOX
#define REP_FOX 1
#endif
constexpr int LDS_SLOT = 156672, LDS_TOTAL = 156688;
constexpr int PH_PER_LAYER = 9, N_PHASES = 1 + DEPTH * PH_PER_LAYER + 1;

__device__ __forceinline__ int fetch_item(unsigned* ctr, unsigned char* lds) {
    volatile int* slot = (volatile int*)(lds + LDS_SLOT);
    __syncthreads();
    if (my_tid() == 0) *slot = (int)atomicAdd(ctr, 1u);
    __syncthreads();
    return *slot;
}

template <class Epi>
__device__ __forceinline__ void run_gemm(unsigned char* lds, const bf16_t* A, const bf16_t* Bt, int M, int N, int K, const Epi& E) {
    pg8::Gemm g{A, Bt, M, N, K}; pg8::StaticOrder S; S.init(M, N, my_gdim(), my_bid());
    pg8::gemm_phase<Epi, pg8::StaticOrder, true, true>((PG8_LAS unsigned char*)lds, g, S, E);
    __syncthreads();
}

__device__ void run_phase(const Params& p, unsigned char* lds, int ph) {
    unsigned char* ws = p.ws;
    float* xs = p.out;
    float* modp = (float*)(ws + WS_MOD);
    bf16_t* hbuf = (bf16_t*)(ws + WS_HBUF);
    if (ph == 0) { phase_prologue(p, lds); return; }
    if (ph == N_PHASES - 1) { phase_final_norm(xs, p.in[I_FNG], p.out); return; }
    const int l = (ph - 1) / PH_PER_LAYER, s = (ph - 1) % PH_PER_LAYER;
    const float* modl = modp + (size_t)l * 4 * 6144;
    const float* xin = (l == 0) ? p.in[I_X] : xs;
    switch (s) {
#ifndef NO_NORM
    case 0:
        phase_norm(p, lds, xin, p.in[I_NMG] + l * DM, modl, 0, 1024, hbuf, (const float*)(ws + WS_WSC) + (size_t)l * 12 * DM, (float*)(ws + WS_SCAL));
        break;
#endif
#ifndef NO_G1
    case 1: {
        pg8::EpiProj E{(bf16_t*)(ws + WS_PAB), (bf16_t*)(ws + WS_PC), (bf16_t*)(ws + WS_PZ)};
        run_gemm(lds, hbuf, (const bf16_t*)(ws + WS_WTIN) + (size_t)l * NPROJ * DM, MTOK, NPROJ, DM, E);
        break; }
#endif
#ifndef NO_MIX
    case 2: {
        unsigned* ctr = (unsigned*)(ws + WS_CTRL) + 8 + l;
        unsigned* uflag = (unsigned*)(ws + WS_FLG); const unsigned fval = (unsigned)l + 1u;
        const bf16_t* pab = (const bf16_t*)(ws + WS_PAB);
        for (;;) {
            const int it = fetch_item(ctr, lds);
            if (it >= 3120) break;
            if (it < 16) { const int bh = it;
                fcum_unit(lds, bh, (const float*)(ws + WS_SCAL), p.in[I_FGB] + l * 4, (float*)(ws + WS_F) , (const bf16_t*)(ws + WS_PAB) + (size_t)(bh >> 2) * SEQ * 1536 + 1024 + (bh & 3) * 64, (float*)(ws + WS_KN) + bh * 128, (const bf16_t*)(ws + WS_PAB) + (size_t)(bh >> 2) * SEQ * 1536 + 256 + (bh & 3) * 64, p.in[I_REL] + (size_t)(l * 4 + (bh & 3)) * 320, (float*)(ws + WS_AB) + bh * 2, uflag + 2048 + bh, fval); }
            else if (it < 48) { const int j = it - 16;
                for (int rep = 0; rep < REP_SCAN; ++rep) { scan_unit(lds, j >> 1, j & 1, ws + WS_PREP, (const float*)(ws + WS_EGL), uflag + (j >> 1) * 128, fval); __syncthreads(); } }
            else if (it < 2096) { const int j = it - 48, n = j >> 4, bh = j & 15, h = bh & 3;
                prep_unit(lds, bh, n, (const bf16_t*)(ws + WS_PC), (const float*)(ws + WS_SCAL), p.in[I_CONVW] + (size_t)l * 4 * 1536, p.in[I_ALOG][l * 4 + h], p.in[I_DTB][l * 4 + h],
                          ws + WS_PREP + (size_t)(bh * 128 + n) * PREP_UNIT, (float*)(ws + WS_EGL), uflag + bh * 128 + n, fval); }
            else if (it < 2608) { const int j = it - 2096, qb = j & 31, bh = j >> 5, b = bh >> 2, h = bh & 3;
                for (int rep = 0; rep < REP_A; ++rep) { attn_unit<1>(lds, b, qb, pab + h * 64, pab + 256 + h * 64, pab + 512 + h * 64, 1536, hbuf + h * 64, DM, nullptr, p.in[I_REL] + (size_t)(l * 4 + h) * 320, (const float*)(ws + WS_AB) + bh * 2, uflag + 2048 + bh, fval); __syncthreads(); } }
            else { const int j = it - 2608, qb = 31 - (j >> 4), bh = j & 15, b = bh >> 2, h = bh & 3;
                for (int rep = 0; rep < REP_FOX; ++rep) { attn_unit<0>(lds, b, qb, pab + 768 + h * 64, pab + 1024 + h * 64, pab + 1280 + h * 64, 1536, hbuf + 256 + h * 64, DM, (const float*)(ws + WS_F) + (size_t)bh * SEQ, nullptr, (const float*)(ws + WS_KN) + bh * 128, uflag + 2048 + bh, fval); __syncthreads(); } }
        }
        break; }
#endif
#ifndef NO_FIN
    case 3:
        phase_finalize(ws + WS_PREP, (const bf16_t*)(ws + WS_PZ), p.in[I_GNG] + l * 128, hbuf);
        break;
#endif
#ifndef NO_G2
    case 4: {
        pg8::EpiRes E{xin, xs, modl + 2048, 0};
        run_gemm(lds, hbuf, (const bf16_t*)(ws + WS_WTOUT) + (size_t)l * DM * DM, MTOK, DM, DM, E);
        break; }
#endif
#ifndef NO_NORM
    case 5:
        phase_norm(p, lds, xs, p.in[I_NFG] + l * DM, modl, 3072, 4096, hbuf, nullptr, nullptr);
        break;
#endif
#ifndef NO_G3
    case 6: {
        pg8::EpiAct E{(bf16_t*)(ws + WS_ACT), p.in[I_FCW] + (size_t)l * 3 * NUP, (float*)(ws + WS_HALO), (float*)(lds + 131072)};
        run_gemm(lds, hbuf, (const bf16_t*)(ws + WS_WTUP) + (size_t)l * NUP * DM, MTOK, NUP, DM, E);
        break; }
#endif
#ifndef NO_ACT
    case 7:
        phase_fixup((const float*)(ws + WS_HALO), p.in[I_FCW] + (size_t)l * 3 * NUP, (bf16_t*)(ws + WS_ACT));
        break;
#endif
#ifndef NO_G4
    case 8: {
        pg8::EpiRes E{xs, xs, modl + 5120, 0};
        run_gemm(lds, (const bf16_t*)(ws + WS_ACT), (const bf16_t*)(ws + WS_WTDN) + (size_t)l * DM * DFF, MTOK, DM, DFF, E);
        break; }
#endif
    }
}

__global__ void __launch_bounds__(NTHR, 2) hybrid_fwd(Params p) {
    extern __shared__ __attribute__((aligned(16))) unsigned char lds[];
    volatile LAS unsigned* st_ = (volatile LAS unsigned*)(lds + LDS_SLOT + 8);
    if (threadIdx.x == 0) { st_[0] = 0u; st_[1] = 0u; }
    __syncthreads();
    (void)xcd_barrier_post((unsigned*)(p.ws + WS_XB), st_);
#ifdef PROBE_SYNC
    cg::this_grid().sync();
    for (int i = 0; i < PROBE_SYNC; ++i) { XcdBarrier xb; xb.bar = (unsigned*)(p.ws + WS_XB); xb.x = xb_xcc_id(); xb.st = st_; xcd_barrier(xb); }
#endif
    for (int ph = p.ph_lo; ph < p.ph_hi; ++ph) {
        Params q = p;
#pragma unroll
        for (int i = 0; i < 18; ++i) asm volatile("" : "+s"(q.in[i]));
        asm volatile("" : "+s"(q.out), "+s"(q.ws));
#ifdef PROBE_MASK
        const unsigned long long t0_ = __builtin_amdgcn_s_memrealtime();
#endif
        run_phase(q, lds, ph);
        if (ph + 1 < p.ph_hi) { if (p.ph_hi > 4096) cg::this_grid().sync();
            else { XcdBarrier xb; xb.bar = (unsigned*)(q.ws + WS_XB); xb.x = xb_xcc_id(); xb.st = (volatile LAS unsigned*)(lds + LDS_SLOT + 8); xcd_barrier(xb); } }
#ifdef PROBE_MASK
        if ((PROBE_MASK >> ph) & 1ull) { const unsigned long long t1_ = __builtin_amdgcn_s_memrealtime(); while (__builtin_amdgcn_s_memrealtime() - t1_ < (t1_ - t0_)) __builtin_amdgcn_s_sleep(8); }
#endif
    }
}

#ifndef N_LAUNCH_MODE
#define N_LAUNCH_MODE 1
#endif

extern "C" void kernel_launch(void* const* d_in, const int* in_sizes, int n_in, void* d_out, int out_size, void* d_ws, size_t ws_size, hipStream_t stream) {
    static int grid = 0;
    if (grid == 0) {
        if (n_in != 18 || out_size != MTOK * DM || ws_size < WS_END) { fprintf(stderr, "kernel_launch: unexpected shapes (n_in %d out %d ws %zu)\n", n_in, out_size, ws_size); grid = -1; return; }
        int dev = 0, cus = 0, per_cu = 0;
        hipGetDevice(&dev); hipDeviceGetAttribute(&cus, hipDeviceAttributeMultiprocessorCount, dev);
        if (hipFuncSetAttribute((const void*)hybrid_fwd, hipFuncAttributeMaxDynamicSharedMemorySize, LDS_TOTAL) != hipSuccess) { fprintf(stderr, "kernel_launch: hipFuncSetAttribute failed\n"); grid = -1; return; }
        if (hipOccupancyMaxActiveBlocksPerMultiprocessor(&per_cu, (const void*)hybrid_fwd, NTHR, LDS_TOTAL) != hipSuccess || per_cu < 1) { fprintf(stderr, "kernel_launch: occupancy query gave %d\n", per_cu); (void)hipGetLastError(); per_cu = 1; }
        grid = cus;
        if (grid <= 0) { grid = -1; return; }
    }
    if (grid < 0) return;
    if (hipMemsetAsync((char*)d_ws + WS_FLG, 0, (WS_XB - WS_FLG) + XCD_BAR_WORDS * 4, stream) != hipSuccess) { fprintf(stderr, "kernel_launch: memset failed\n"); return; }
    Params p{};
    for (int i = 0; i < 18; ++i) p.in[i] = (const float*)d_in[i];
    p.out = (float*)d_out; p.ws = (unsigned char*)d_ws;
#if N_LAUNCH_MODE == 1
    p.ph_lo = 0; p.ph_hi = N_PHASES;
    void* args[] = {&p};
    hipError_t e = hipLaunchCooperativeKernel((const void*)hybrid_fwd, dim3(grid), dim3(NTHR), args, LDS_TOTAL, stream);
    if (e != hipSuccess) fprintf(stderr, "kernel_launch: cooperative launch failed: %s (grid %d)\n", hipGetErrorString(e), grid);
#else
    for (int ph = 0; ph < N_PHASES; ++ph) { p.ph_lo = ph; p.ph_hi = ph + 1; hipLaunchKernelGGL(hybrid_fwd, dim3(grid), dim3(NTHR), LDS_TOTAL, stream, p); }
#endif
}
```

```cpp
#include <hip/hip_runtime.h>
#include <hip/hip_cooperative_groups.h>
#include <cstdio>
#include <cstdint>
namespace cg = cooperative_groups;
__device__ __forceinline__ int my_tid() { int t = (int)threadIdx.x; asm volatile("" : "+v"(t)); return t; }
__device__ __forceinline__ int my_bid() { int t = (int)blockIdx.x; asm volatile("" : "+s"(t)); return t; }
__device__ __forceinline__ int my_gdim() { int t = (int)gridDim.x; asm volatile("" : "+s"(t)); return t; }
namespace pg8 {
#define PG8_LAS __attribute__((address_space(3)))
typedef unsigned short bf16_t;
typedef short bf16x8 __attribute__((ext_vector_type(8)));
typedef float f32x4 __attribute__((ext_vector_type(4)));
typedef unsigned u32x4 __attribute__((ext_vector_type(4)));
constexpr int BM = 256, BK = 64, HALF = 128, HTB = HALF * BK * 2  , STAGE_BYTES = 8 * HTB, NXCD = 8, WGM = 8;

__host__ __device__ __forceinline__ int lds_byte(int r, int c) { const int st = (r >> 4) * 2 + (c >> 5), rr = r & 15, cc = c & 31, ob = rr * 64 + cc * 2; return st * 1024 + (ob ^ (((ob >> 9) & 1) << 5)); }
__host__ __device__ __forceinline__ void stage_rc(int b, int& R, int& C) { const int st = b / 1024, sb = b % 1024, swz = sb ^ (((sb >> 9) & 1) << 5); R = (st >> 1) * 16 + swz / 64; C = (st & 1) * 32 + (swz % 64) / 2; }
__host__ __device__ __forceinline__ int perm32(int rho) { const int n = rho >> 4, i = rho & 15; return 8 * (i >> 2) + 4 * n + (i & 3); }

struct Unit { int pm, pn; };
struct Gemm { const bf16_t* A; const bf16_t* Bt; int M, N, K; };

struct StaticOrder {
    int nM, nN, nwg, G, c;
    __host__ __device__ void init(int M, int N, int G_, int c_) { nM = M / BM; nN = N / BM; nwg = nM * nN; G = G_; c = c_; }
    __host__ __device__ bool next(int i, Unit& u) const {
        const long L = (long)i * G + c; if (L >= nwg) return false;
        int wgid = (int)L; { const int q = nwg / NXCD, r = nwg % NXCD, xcd = wgid % NXCD, off = wgid / NXCD; wgid = (xcd < r ? xcd * (q + 1) : r * (q + 1) + (xcd - r) * q) + off; }
        const int nig = WGM * nN, gid = wgid / nig, fm = gid * WGM, gsz = (nM - fm) < WGM ? (nM - fm) : WGM;
        u.pm = fm + ((wgid % nig) % gsz); u.pn = (wgid % nig) / gsz; return true;
    }
    __device__ __forceinline__ void a_ready(const Unit&) const {}
    __device__ __forceinline__ void done(const Unit&) const {}
};
typedef float f32x2_t_ __attribute__((ext_vector_type(2))); typedef __bf16 bf16x2_t_ __attribute__((ext_vector_type(2)));
__device__ __forceinline__ unsigned cvt_pk_bf16(float lo, float hi) { f32x2_t_ v = {lo, hi}; bf16x2_t_ b = __builtin_convertvector(v, bf16x2_t_); return __builtin_bit_cast(unsigned, b); }
template <class Epi, class Sched, bool ALIGN_EPI = false, bool SP2 = false>
__device__ __forceinline__ void gemm_phase(PG8_LAS unsigned char* lds, const Gemm g, const Sched& S, const Epi& E) {
    const int tid = my_tid(), wid = __builtin_amdgcn_readfirstlane(tid >> 6), lane = tid & 63, wr = wid >> 2, wc = wid & 3, fr = lane & 15, fq = lane >> 4;
    const int K = g.K, nt = K / BK;
    unsigned voffA[2], voffB[2];
#pragma unroll
    for (int i = 0; i < 2; ++i) { int R, C; stage_rc(tid * 16 + i * 8192, R, C); const int Rb = Epi::PERM ? ((R & ~31) + perm32(R & 31)) : R;
        voffA[i] = (unsigned)(R * K + C) * 2u; voffB[i] = (unsigned)(Rb * K + C) * 2u; }
    const size_t kstep = (size_t)(BK * 2);
    const size_t hstep = (size_t)HALF * K * 2;
    const size_t tstep = 2 * hstep;
    const unsigned ldsw = (unsigned)wid * 1024u;
    const int aoff = lds_byte(wr * 64 + fr, fq * 8), boff = lds_byte(wc * 32 + fr, fq * 8);
#define PG8_SA(b, h) (((b) * 2 + (h)) * HTB)
#define PG8_SB(b, h) ((4 + (b) * 2 + (h)) * HTB)
#define PG8_STAGE(bufoff, gbase, voff) do { _Pragma("unroll") for (int _i = 0; _i < 2; ++_i) \
        __builtin_amdgcn_global_load_lds((const unsigned*)((const char*)(gbase) + (voff)[_i]), (PG8_LAS unsigned*)(lds + (bufoff) + ldsw + _i * 8192), 16, 0, 0); } while (0)
#define PG8_LDA(dst, b, h) do { _Pragma("unroll") for (int m = 0; m < 4; ++m) _Pragma("unroll") for (int k = 0; k < 2; ++k) dst[m][k] = *(const PG8_LAS bf16x8*)(lds + PG8_SA(b, h) + aoff + m * 2048 + k * 1024); } while (0)
#define PG8_LDB(dst, b, h) do { _Pragma("unroll") for (int n = 0; n < 2; ++n) _Pragma("unroll") for (int k = 0; k < 2; ++k) dst[n][k] = *(const PG8_LAS bf16x8*)(lds + PG8_SB(b, h) + boff + n * 2048 + k * 1024); } while (0)
#define PG8_MMA(ai, bj, At, Bt) do { __builtin_amdgcn_s_setprio(1); _Pragma("unroll") for (int m = 0; m < 4; ++m) _Pragma("unroll") for (int n = 0; n < 2; ++n) _Pragma("unroll") for (int k = 0; k < 2; ++k) \
        acc[ai][bj][m][n] = __builtin_amdgcn_mfma_f32_16x16x32_bf16(Bt[n][k], At[m][k], acc[ai][bj][m][n], 0, 0, 0); __builtin_amdgcn_s_setprio(0); } while (0)
#define PG8_WAIT_V(n) asm volatile("s_waitcnt vmcnt(" #n ")" ::: "memory")
#define PG8_WAIT_L(n) asm volatile("s_waitcnt lgkmcnt(" #n ")" ::: "memory")
#define PG8_BAR __builtin_amdgcn_s_barrier()
#define PG8_SCHED __builtin_amdgcn_sched_barrier(0)
    Unit cur, nxt; int ui = 0;
    if (!S.next(0, cur)) return;
    f32x4 acc[2][2][4][2];
#pragma unroll
    for (int a = 0; a < 2; ++a)
#pragma unroll
        for (int b = 0; b < 2; ++b)
#pragma unroll
            for (int m = 0; m < 4; ++m)
#pragma unroll
                for (int n = 0; n < 2; ++n) acc[a][b][m][n] = (f32x4){0.f, 0.f, 0.f, 0.f};
    bf16x8 At[4][2], B0[2][2], B1[2][2];
    const char* cA = (const char*)g.A + (size_t)cur.pm * tstep; const char* cB = (const char*)g.Bt + (size_t)cur.pn * tstep;
    S.a_ready(cur);
    if constexpr (SP2) {
        PG8_STAGE(PG8_SB(0, 0), cB, voffB); PG8_STAGE(PG8_SB(0, 1), cB + hstep, voffB); PG8_STAGE(PG8_SA(0, 0), cA, voffA); PG8_STAGE(PG8_SA(0, 1), cA + hstep, voffA);
        if (wr == 1) PG8_BAR;
        PG8_WAIT_V(2); PG8_BAR;
        PG8_STAGE(PG8_SB(1, 0), cB + kstep, voffB); PG8_STAGE(PG8_SA(1, 0), cA + kstep, voffA); PG8_STAGE(PG8_SB(1, 1), cB + hstep + kstep, voffB);
        PG8_WAIT_V(6); PG8_BAR;
    } else {
        PG8_STAGE(PG8_SB(0, 0), cB, voffB); PG8_STAGE(PG8_SA(0, 0), cA, voffA); PG8_STAGE(PG8_SB(0, 1), cB + hstep, voffB); PG8_STAGE(PG8_SA(0, 1), cA + hstep, voffA);
        if (wr == 1) PG8_BAR;
        PG8_WAIT_V(4); PG8_BAR;
        PG8_STAGE(PG8_SB(1, 0), cB + kstep, voffB); PG8_STAGE(PG8_SA(1, 0), cA + kstep, voffA); PG8_STAGE(PG8_SB(1, 1), cB + hstep + kstep, voffB);
        PG8_WAIT_V(6); PG8_BAR;
    }
    for (;;) {
        const bool has_next = S.next(ui + 1, nxt);
        const char* nA = has_next ? (const char*)g.A + (size_t)nxt.pm * tstep : cA; const char* nB = has_next ? (const char*)g.Bt + (size_t)nxt.pn * tstep : cB;
        for (int t = 0; t < nt; t += 2) {
            const bool last = (t == nt - 2);
            const char* a1 = cA + (size_t)(t + 1) * kstep;
            const char* a2 = last ? nA : cA + (size_t)(t + 2) * kstep; const char* b2 = last ? nB : cB + (size_t)(t + 2) * kstep;
            const char* a3 = a2 + kstep; const char* b3 = b2 + kstep;
            if (last && has_next) S.a_ready(nxt);
            if constexpr (SP2) {
            PG8_LDB(B0, 0, 0); PG8_LDB(B1, 0, 1); PG8_SCHED; PG8_LDA(At, 0, 0); PG8_STAGE(PG8_SA(1, 1), a1 + hstep, voffA);
            PG8_WAIT_V(8); PG8_WAIT_L(0); PG8_BAR; PG8_MMA(0, 0, At, B0); PG8_MMA(0, 1, At, B1); PG8_BAR; PG8_SCHED;
            PG8_LDA(At, 0, 1); PG8_STAGE(PG8_SB(0, 0), b2, voffB); PG8_STAGE(PG8_SB(0, 1), b2 + hstep, voffB); PG8_STAGE(PG8_SA(0, 0), a2, voffA);
            PG8_WAIT_V(8); PG8_WAIT_L(0); PG8_BAR; PG8_MMA(1, 0, At, B0); PG8_MMA(1, 1, At, B1); PG8_BAR; PG8_SCHED;
            PG8_LDB(B0, 1, 0); PG8_LDB(B1, 1, 1); PG8_SCHED; PG8_LDA(At, 1, 0); PG8_STAGE(PG8_SA(0, 1), a2 + hstep, voffA);
            PG8_WAIT_V(8); PG8_WAIT_L(0); PG8_BAR; PG8_MMA(0, 0, At, B0); PG8_MMA(0, 1, At, B1); PG8_BAR; PG8_SCHED;
            PG8_LDA(At, 1, 1); PG8_STAGE(PG8_SB(1, 0), b3, voffB); PG8_STAGE(PG8_SB(1, 1), b3 + hstep, voffB); PG8_STAGE(PG8_SA(1, 0), a3, voffA);
            PG8_WAIT_V(8); PG8_WAIT_L(0); PG8_BAR; PG8_MMA(1, 0, At, B0); PG8_MMA(1, 1, At, B1); PG8_BAR; PG8_SCHED;
            } else {
            PG8_LDB(B0, 0, 0); PG8_SCHED; PG8_LDA(At, 0, 0); PG8_STAGE(PG8_SA(1, 1), a1 + hstep, voffA);
            PG8_WAIT_L(8); PG8_BAR; PG8_WAIT_L(0); PG8_MMA(0, 0, At, B0); PG8_BAR; PG8_SCHED;
            PG8_LDB(B1, 0, 1); PG8_STAGE(PG8_SB(0, 0), b2, voffB);
            PG8_BAR; PG8_WAIT_L(0); PG8_MMA(0, 1, At, B1); PG8_BAR;
            PG8_LDA(At, 0, 1); PG8_STAGE(PG8_SA(0, 0), a2, voffA);
            PG8_BAR; PG8_WAIT_L(0); PG8_MMA(1, 0, At, B0); PG8_BAR; PG8_SCHED;
            PG8_STAGE(PG8_SB(0, 1), b2 + hstep, voffB);
            PG8_WAIT_V(6); PG8_BAR; PG8_MMA(1, 1, At, B1); PG8_BAR;
            PG8_LDB(B0, 1, 0); PG8_SCHED; PG8_LDA(At, 1, 0); PG8_STAGE(PG8_SA(0, 1), a2 + hstep, voffA);
            PG8_WAIT_L(8); PG8_BAR; PG8_WAIT_L(0); PG8_MMA(0, 0, At, B0); PG8_BAR; PG8_SCHED;
            PG8_LDB(B1, 1, 1); PG8_STAGE(PG8_SB(1, 0), b3, voffB);
            PG8_BAR; PG8_WAIT_L(0); PG8_MMA(0, 1, At, B1); PG8_BAR;
            PG8_LDA(At, 1, 1); PG8_STAGE(PG8_SA(1, 0), a3, voffA);
            PG8_BAR; PG8_WAIT_L(0); PG8_MMA(1, 0, At, B0); PG8_BAR; PG8_SCHED;
            PG8_STAGE(PG8_SB(1, 1), b3 + hstep, voffB);
            PG8_WAIT_V(6); PG8_BAR; PG8_MMA(1, 1, At, B1); PG8_BAR;
            }
        }
        if constexpr (ALIGN_EPI) { if (wr == 0) PG8_BAR; }
        if constexpr (!Epi::AFTER_DRAIN) { E(acc, cur, wr, wc, fr, fq); S.done(cur); }
        if (!has_next) break;
#pragma unroll
        for (int a = 0; a < 2; ++a)
#pragma unroll
            for (int b = 0; b < 2; ++b)
#pragma unroll
                for (int m = 0; m < 4; ++m)
#pragma unroll
                    for (int n = 0; n < 2; ++n) acc[a][b][m][n] = (f32x4){0.f, 0.f, 0.f, 0.f};
        cur = nxt; cA = nA; cB = nB; ++ui;
        if constexpr (ALIGN_EPI) { if (wr == 1) PG8_BAR; }
    }
    PG8_WAIT_V(0);
    if constexpr (!ALIGN_EPI) { if (wr == 0) PG8_BAR; }
    PG8_BAR;
    if constexpr (Epi::AFTER_DRAIN) { E.fused(acc, cur, wr, wc, fr, fq, lds, wid, lane); S.done(cur); }
#undef PG8_SA
#undef PG8_SB
#undef PG8_STAGE
#undef PG8_LDA
#undef PG8_LDB
#undef PG8_MMA
#undef PG8_WAIT_V
#undef PG8_WAIT_L
#undef PG8_BAR
#undef PG8_SCHED
}
}
#define XB_TMO      128
#define XB_XCNT(j)  (256  + 64 * (j))
#define XB_XSUB(j)  (1280 + 64 * (j))
#define XB_XGEN(j)  (2304 + 64 * (j))
#define XB_TOP      3328
#define XB_TOPGEN   3392
#define XCD_BAR_WORDS 3456
#define XB_SPIN_CAP (1u << 18)
#define LAS __attribute__((address_space(3)))

__device__ __forceinline__ unsigned xb_ld(unsigned* p)              { return __hip_atomic_load(p, __ATOMIC_RELAXED, __HIP_MEMORY_SCOPE_AGENT); }
__device__ __forceinline__ unsigned xb_add(unsigned* p, unsigned v) { return __hip_atomic_fetch_add(p, v, __ATOMIC_RELAXED, __HIP_MEMORY_SCOPE_AGENT); }
__device__ __forceinline__ unsigned xb_xcc_id() { return (unsigned)__builtin_amdgcn_s_getreg((3 << 11) | 20) & 0xFu; }
#define XB_SPIN(cond, bar) do { unsigned _sp = 0; while (cond) { __builtin_amdgcn_s_sleep(1); \
    if ((++_sp & 255u) == 0u) { if (xb_ld(&(bar)[XB_TMO])) break; if (_sp > XB_SPIN_CAP) { atomicAdd(&(bar)[XB_TMO], 1u); break; } } } } while (0)

struct XcdBarrier {
    unsigned* bar; unsigned x;
    volatile LAS unsigned* st;
};

__device__ __forceinline__ XcdBarrier xcd_barrier_post(unsigned* bar, volatile LAS unsigned* st) {
    XcdBarrier b; b.bar = bar; b.x = xb_xcc_id(); b.st = st;
    if (threadIdx.x == 0) (void)xb_add(&bar[XB_XCNT(b.x)], 1u);
    return b;
}
__device__ __forceinline__ void xcd_barrier_complete(unsigned* bar, unsigned x, unsigned& nloc, unsigned& nx) {
    const unsigned G = gridDim.x * gridDim.y * gridDim.z;
    unsigned sum, cnt, mine, sp = 0u;
    for (;;) {
        sum = 0u; cnt = 0u; mine = 0u;
#pragma unroll
        for (unsigned j = 0; j < 16; ++j) { const unsigned c = xb_ld(&bar[XB_XCNT(j)]); sum += c; cnt += (c > 0u) ? 1u : 0u; mine = (j == x) ? c : mine; }
        if (sum == G) break;
        __builtin_amdgcn_s_sleep(1);
        if ((++sp & 255u) == 0u) { if (xb_ld(&bar[XB_TMO])) break; if (sp > XB_SPIN_CAP) { atomicAdd(&bar[XB_TMO], 1u); break; } }
    }
    nloc = mine > 0u ? mine : 1u; nx = cnt > 0u ? cnt : 1u;
}

__device__ __forceinline__ void xcd_barrier(const XcdBarrier& b) {
    asm volatile("s_waitcnt vmcnt(0)" ::: "memory");
    __syncthreads();
    if (threadIdx.x == 0) {
        unsigned* bar = b.bar;
        __builtin_amdgcn_s_waitcnt(0);
        unsigned nloc = b.st[0], nx = b.st[1];
        if (nloc == 0u) { xcd_barrier_complete(bar, b.x, nloc, nx); b.st[0] = nloc; b.st[1] = nx; }
        const unsigned old = xb_add(&bar[XB_XSUB(b.x)], 1u);
        const unsigned gen = old / nloc;
        if (old + 1u == (gen + 1u) * nloc) {
            __builtin_amdgcn_fence(__ATOMIC_RELEASE, "agent");
            asm volatile("s_waitcnt vmcnt(0)" ::: "memory");
            const unsigned og = xb_add(&bar[XB_TOP], 1u);
            const unsigned tg = og / nx;
            if (og + 1u == (tg + 1u) * nx) xb_add(&bar[XB_TOPGEN], 1u);
            else XB_SPIN(xb_ld(&bar[XB_TOPGEN]) == tg, bar);
            __builtin_amdgcn_fence(__ATOMIC_ACQUIRE, "agent");
            xb_add(&bar[XB_XGEN(b.x)], 1u);
            asm volatile("s_waitcnt vmcnt(0)" ::: "memory");
        } else {
            XB_SPIN(xb_ld(&bar[XB_XGEN(b.x)]) == gen, bar);
            __builtin_amdgcn_fence(__ATOMIC_ACQUIRE, "agent");
            asm volatile("s_waitcnt vmcnt(0)" ::: "memory");
        }
    }
    __syncthreads();
}


typedef unsigned short bf16_t;
typedef short bf16x8 __attribute__((ext_vector_type(8)));
typedef float f32x4 __attribute__((ext_vector_type(4)));
typedef unsigned u32x4 __attribute__((ext_vector_type(4)));
typedef unsigned u32x2 __attribute__((ext_vector_type(2)));

constexpr int NB = 4, SEQ = 8192, DM = 1024, MTOK = NB * SEQ, DEPTH = 2;
constexpr int DIN = 3596, NPROJ = 3584, DFF = 2816, NUP = 5632;
constexpr int NTHR = 512;
constexpr float LOG2E = 1.4426950408889634f;
constexpr float QSCALE = 0.125f * LOG2E;
constexpr float EPS = 1e-6f;
constexpr int MHALF = MTOK / 2;

constexpr size_t MiB = 1048576;
constexpr size_t WS_CTRL = 0;
constexpr size_t WS_MOD  = 4096;
constexpr size_t WS_WSC  = WS_MOD + 2 * 4 * 6144 * 4;
constexpr size_t WS_F    = WS_WSC + 2 * 12 * 1024 * 4;
constexpr size_t WS_EGL  = WS_F + 16 * 8192 * 4;
constexpr size_t WS_KN   = 835584;
constexpr size_t WS_AB   = 843776;
constexpr size_t WS_FLG  = 905216;
constexpr size_t WS_XB   = 921600;
constexpr size_t WS_SCAL = 1 * MiB;
constexpr size_t WS_WTIN = 3 * MiB;
constexpr size_t WS_WTOUT = 17 * MiB;
constexpr size_t WS_WTUP = 21 * MiB;
constexpr size_t WS_WTDN = 43 * MiB;
constexpr size_t WS_HBUF = 54 * MiB;
constexpr size_t WS_R1   = 118 * MiB;
constexpr size_t WS_PAB  = WS_R1;
constexpr size_t WS_PC   = WS_R1 + 96 * MiB;
constexpr size_t WS_PZ   = WS_R1 + 192 * MiB;
constexpr size_t WS_PREP = WS_R1 + 224 * MiB;
constexpr size_t WS_UH   = WS_R1;
constexpr size_t WS_ACT  = WS_R1 + 176 * MiB;
constexpr size_t WS_HALO = WS_R1 + 352 * MiB;
constexpr size_t WS_END  = WS_R1 + 368 * MiB;
constexpr int PREP_UNIT = 73728;
constexpr int LDS_BYTES = 156672;
constexpr int LDS_SLOT_C = 156672;

struct Params {
    const float* in[18];
    float* out;
    unsigned char* ws;
    int ph_lo, ph_hi;
};
enum { I_X = 0, I_C, I_ADAW, I_ADAB, I_NMG, I_NFG, I_WIN, I_WOUT, I_REL, I_FGB, I_CONVW, I_ALOG, I_DTB, I_GNG, I_WUP, I_FCW, I_WDN, I_FNG };

__device__ __forceinline__ float bf2f(unsigned v) { return __uint_as_float(v << 16); }
__device__ __forceinline__ unsigned pack2(float lo, float hi) { return pg8::cvt_pk_bf16(lo, hi); }
__device__ __forceinline__ float dpp_row_shr_(float v, int ctrl_sel) {
    const int iv = __builtin_bit_cast(int, v); int r;
    switch (ctrl_sel) { case 1: r = __builtin_amdgcn_update_dpp(0, iv, 0x111, 0xf, 0xf, true); break; case 2: r = __builtin_amdgcn_update_dpp(0, iv, 0x112, 0xf, 0xf, true); break;
                        case 4: r = __builtin_amdgcn_update_dpp(0, iv, 0x114, 0xf, 0xf, true); break; default: r = __builtin_amdgcn_update_dpp(0, iv, 0x118, 0xf, 0xf, true); break; }
    return __builtin_bit_cast(float, r);
}
__device__ __forceinline__ float wave_sum(float v) {
    v += dpp_row_shr_(v, 1); v += dpp_row_shr_(v, 2); v += dpp_row_shr_(v, 4); v += dpp_row_shr_(v, 8);
    v += __builtin_bit_cast(float, __builtin_amdgcn_update_dpp(0, __builtin_bit_cast(int, v), 0x142, 0xa, 0xf, false));
    v += __builtin_bit_cast(float, __builtin_amdgcn_update_dpp(0, __builtin_bit_cast(int, v), 0x143, 0xc, 0xf, false));
    return __builtin_bit_cast(float, __builtin_amdgcn_readlane(__builtin_bit_cast(int, v), 63));
}
__device__ __forceinline__ float silu_f(float x) { return x * __builtin_amdgcn_rcpf(1.0f + __expf(-x)); }
__device__ __forceinline__ float softplus_f(float x) { return fmaxf(x, 0.f) + log1pf(__expf(-fabsf(x))); }
__device__ __forceinline__ void unpack8(const u32x4 v, float* f) {
#pragma unroll
    for (int i = 0; i < 4; ++i) { f[2 * i] = __uint_as_float(v[i] << 16); f[2 * i + 1] = __uint_as_float(v[i] & 0xffff0000u); }
}
__device__ __forceinline__ void handoff_publish(unsigned* flag, unsigned val) {
    asm volatile("s_waitcnt vmcnt(0)" ::: "memory");
    __syncthreads();
    if (threadIdx.x == 0) {
        __builtin_amdgcn_fence(__ATOMIC_RELEASE, "agent");
        asm volatile("s_waitcnt vmcnt(0)" ::: "memory");
        __hip_atomic_store(flag, val, __ATOMIC_RELAXED, __HIP_MEMORY_SCOPE_AGENT);
    }
}
__device__ __forceinline__ void handoff_publish_wt(unsigned* flag, unsigned val) {
    asm volatile("s_waitcnt vmcnt(0)" ::: "memory");
    __syncthreads();
    if (threadIdx.x == 0) __hip_atomic_store(flag, val, __ATOMIC_RELAXED, __HIP_MEMORY_SCOPE_AGENT);
}
__device__ __forceinline__ void handoff_wait_one(const unsigned* flag, unsigned val) {
    if (threadIdx.x == 0) {
        while (__hip_atomic_load(flag, __ATOMIC_RELAXED, __HIP_MEMORY_SCOPE_AGENT) < val) __builtin_amdgcn_s_sleep(4);
        __builtin_amdgcn_fence(__ATOMIC_ACQUIRE, "agent");
        asm volatile("s_waitcnt vmcnt(0)" ::: "memory");
    }
    __syncthreads();
}
#define MFMA16(a, b, c) __builtin_amdgcn_mfma_f32_16x16x32_bf16((a), (b), (c), 0, 0, 0)

namespace pg8 {
struct EpiProj {
    static constexpr bool PERM = true, AFTER_DRAIN = false;
    bf16_t* pab; bf16_t* pc; bf16_t* pz;
    __device__ __forceinline__ void operator()(const f32x4 (&acc)[2][2][4][2], const Unit& u, int wr, int wc, int fr, int fq) const {
        bf16_t* base; int ldc, colt; float sc = 1.f;
        if (u.pn < 6) { base = pab; ldc = 1536; colt = u.pn * 256; if (u.pn == 0 || u.pn == 3) sc = QSCALE; }
        else if (u.pn < 12) { base = pc; ldc = 1536; colt = (u.pn - 6) * 256; }
        else { base = pz; ldc = 512; colt = (u.pn - 12) * 256; }
        const int row0 = u.pm * BM + wr * 64 + fr, col0 = colt + wc * 32 + 8 * fq;
#pragma unroll
        for (int ai = 0; ai < 2; ++ai)
#pragma unroll
            for (int m = 0; m < 4; ++m) { bf16_t* rowp = base + (size_t)(row0 + ai * HALF + m * 16) * ldc + col0;
#pragma unroll
                for (int bj = 0; bj < 2; ++bj) { const f32x4 v0 = acc[ai][bj][m][0] * sc, v1 = acc[ai][bj][m][1] * sc;
                    u32x4 w; w.x = cvt_pk_bf16(v0[0], v0[1]); w.y = cvt_pk_bf16(v0[2], v0[3]); w.z = cvt_pk_bf16(v1[0], v1[1]); w.w = cvt_pk_bf16(v1[2], v1[3]);
                    *(u32x4*)(rowp + bj * HALF) = w; } }
    }
};
struct EpiPlain {
    static constexpr bool PERM = true, AFTER_DRAIN = false;
    bf16_t* O; int ldc;
    __device__ __forceinline__ void operator()(const f32x4 (&acc)[2][2][4][2], const Unit& u, int wr, int wc, int fr, int fq) const {
        const int row0 = u.pm * BM + wr * 64 + fr, col0 = u.pn * BM + wc * 32 + 8 * fq;
#pragma unroll
        for (int ai = 0; ai < 2; ++ai)
#pragma unroll
            for (int m = 0; m < 4; ++m) { bf16_t* rowp = O + (size_t)(row0 + ai * HALF + m * 16) * ldc + col0;
#pragma unroll
                for (int bj = 0; bj < 2; ++bj) { const f32x4 v0 = acc[ai][bj][m][0], v1 = acc[ai][bj][m][1];
                    u32x4 w; w.x = cvt_pk_bf16(v0[0], v0[1]); w.y = cvt_pk_bf16(v0[2], v0[3]); w.z = cvt_pk_bf16(v1[0], v1[1]); w.w = cvt_pk_bf16(v1[2], v1[3]);
                    *(u32x4*)(rowp + bj * HALF) = w; } }
    }
};
struct EpiRes {
    static constexpr bool PERM = false, AFTER_DRAIN = false;
    const float* base; float* out; const float* gate; int row_off;
    __device__ __forceinline__ void operator()(const f32x4 (&acc)[2][2][4][2], const Unit& u, int wr, int wc, int fr, int fq) const {
        const int col0 = u.pn * BM + wc * 32 + 4 * fq;
        const int rbase = row_off + u.pm * BM;
        const float* gp = gate + (size_t)(rbase >> 13) * 6144 + col0;
        f32x4 gv[2][2];
#pragma unroll
        for (int bj = 0; bj < 2; ++bj)
#pragma unroll
            for (int n = 0; n < 2; ++n) gv[bj][n] = *(const f32x4*)(gp + bj * HALF + n * 16);
#pragma unroll
        for (int ai = 0; ai < 2; ++ai) {
            f32x4 bs[4][2][2];
#pragma unroll
            for (int m = 0; m < 4; ++m) { const size_t off = (size_t)(rbase + ai * HALF + wr * 64 + m * 16 + fr) * 1024 + col0;
#pragma unroll
                for (int bj = 0; bj < 2; ++bj)
#pragma unroll
                    for (int n = 0; n < 2; ++n) bs[m][bj][n] = *(const f32x4*)(base + off + bj * HALF + n * 16); }
            __builtin_amdgcn_sched_barrier(0);
#pragma unroll
            for (int m = 0; m < 4; ++m) { const size_t off = (size_t)(rbase + ai * HALF + wr * 64 + m * 16 + fr) * 1024 + col0;
#pragma unroll
                for (int bj = 0; bj < 2; ++bj)
#pragma unroll
                    for (int n = 0; n < 2; ++n) *(f32x4*)(out + off + bj * HALF + n * 16) = bs[m][bj][n] + gv[bj][n] * acc[ai][bj][m][n]; }
            __builtin_amdgcn_sched_barrier(0);
        }
    }
};

__device__ __forceinline__ float dpp_ror1(float v) { return __builtin_bit_cast(float, __builtin_amdgcn_update_dpp(0, __builtin_bit_cast(int, v), 0x121, 0xf, 0xf, false)); }
__device__ __forceinline__ float dpp_ror2(float v) { return __builtin_bit_cast(float, __builtin_amdgcn_update_dpp(0, __builtin_bit_cast(int, v), 0x122, 0xf, 0xf, false)); }
struct EpiAct {
    static constexpr bool PERM = true, AFTER_DRAIN = false;
    bf16_t* act; const float* cw; float* halo; float* xch;
    __device__ __forceinline__ void operator()(const f32x4 (&acc)[2][2][4][2], const Unit& u, int wr, int wc, int fr, int fq) const {
        const int wid = wr * 4 + wc;
        float* myx = xch + wid * 256;
        if (fr >= 14) {
#pragma unroll
            for (int ai = 0; ai < 2; ++ai)
#pragma unroll
                for (int bj = 0; bj < 2; ++bj)
#pragma unroll
                    for (int n = 0; n < 2; ++n) *(f32x4*)(myx + (ai * 2 + (fr - 14)) * 64 + bj * 32 + fq * 8 + n * 4) = acc[ai][bj][3][n];
        }
        asm volatile("s_waitcnt lgkmcnt(0)\n\ts_barrier" ::: "memory");
        const int colj = u.pn * 128 + wc * 32 + 8 * fq;
        float* hb = halo + (size_t)(u.pm * 22 + u.pn) * 1024 + wc * 32 + 8 * fq;
#pragma unroll
        for (int n = 0; n < 2; ++n) {
            f32x4 wgt[3][2];
#pragma unroll
            for (int i = 0; i < 3; ++i)
#pragma unroll
                for (int bj = 0; bj < 2; ++bj) wgt[i][bj] = *(const f32x4*)(cw + i * 5632 + bj * 2816 + colj + 4 * n);
#pragma unroll
            for (int ai = 0; ai < 2; ++ai) {
                const bool top = (wr == 0 && ai == 0);
                f32x4 h1[2], h2[2];
                const float* sx = xch + (wr == 1 ? wc : 4 + wc) * 256 + (wr == 1 ? ai * 2 : 0) * 64 + fq * 8 + n * 4;
#pragma unroll
                for (int bj = 0; bj < 2; ++bj) {
                    if (!top) { h2[bj] = *(const f32x4*)(sx + bj * 32); h1[bj] = *(const f32x4*)(sx + 64 + bj * 32); }
                    else { h2[bj] = (f32x4){0.f, 0.f, 0.f, 0.f}; h1[bj] = (f32x4){0.f, 0.f, 0.f, 0.f}; }
                }
#pragma unroll
                for (int m = 0; m < 4; ++m) {
                    float cv[2][4];
#pragma unroll
                    for (int bj = 0; bj < 2; ++bj)
#pragma unroll
                        for (int e = 0; e < 4; ++e) {
                            const float x = acc[ai][bj][m][n][e];
                            const float r1s = dpp_ror1(x), r2s = dpp_ror2(x);
                            float r1p, r2p;
                            if (m > 0) { const float xp = acc[ai][bj][m > 0 ? m - 1 : 0][n][e]; r1p = dpp_ror1(xp); r2p = dpp_ror2(xp); }
                            else { r1p = h1[bj][e]; r2p = (fr == 0) ? h2[bj][e] : h1[bj][e]; }
                            const float p1 = (fr == 0) ? r1p : r1s, p2 = (fr < 2) ? r2p : r2s;
                            cv[bj][e] = wgt[0][bj][e] * p2 + wgt[1][bj][e] * p1 + wgt[2][bj][e] * x;
                        }
                    const int r = u.pm * BM + ai * HALF + wr * 64 + m * 16 + fr;
                    if (top && m == 0 && fr < 2) {
#pragma unroll
                        for (int bj = 0; bj < 2; ++bj) *(f32x4*)(hb + fr * 256 + bj * 128 + 4 * n) = acc[0][bj][0][n];
                    } else {
                        float o[4];
#pragma unroll
                        for (int c = 0; c < 4; ++c) { const float g = cv[0][c]; o[c] = g * __builtin_amdgcn_rcpf(1.0f + __expf(-g)) * cv[1][c]; }
                        u32x2 w; w.x = cvt_pk_bf16(o[0], o[1]); w.y = cvt_pk_bf16(o[2], o[3]);
                        *(u32x2*)(act + (size_t)r * 2816 + colj + 4 * n) = w;
                    }
                }
            }
        }
        if (wr == 1 && fr >= 14) {
#pragma unroll
            for (int bj = 0; bj < 2; ++bj)
#pragma unroll
                for (int n = 0; n < 2; ++n) *(f32x4*)(hb + (2 + fr - 14) * 256 + bj * 128 + 4 * n) = acc[1][bj][3][n];
        }
    }
};
}

__device__ __forceinline__ void transpose_tile(float* tile  , const float* src, int lds_, int scol0, int k0, bf16_t* dst, int ldd, int drow0) {
    const int tid = my_tid();
#pragma unroll
    for (int i = 0; i < 2; ++i) { const int idx = tid + NTHR * i, kk = idx >> 4, n4 = (idx & 15) * 4;
        const f32x4 v = *(const f32x4*)(src + (size_t)(k0 + kk) * lds_ + scol0 + n4);
        tile[kk * 65 + n4] = v[0]; tile[kk * 65 + n4 + 1] = v[1]; tile[kk * 65 + n4 + 2] = v[2]; tile[kk * 65 + n4 + 3] = v[3]; }
    __syncthreads();
    { const int nn = tid >> 3, k8 = (tid & 7) * 8;
        u32x4 w;
        w.x = pack2(tile[(k8 + 0) * 65 + nn], tile[(k8 + 1) * 65 + nn]); w.y = pack2(tile[(k8 + 2) * 65 + nn], tile[(k8 + 3) * 65 + nn]);
        w.z = pack2(tile[(k8 + 4) * 65 + nn], tile[(k8 + 5) * 65 + nn]); w.w = pack2(tile[(k8 + 6) * 65 + nn], tile[(k8 + 7) * 65 + nn]);
        *(u32x4*)(dst + (size_t)(drow0 + nn) * ldd + k0 + k8) = w; }
    __syncthreads();
}

__device__ void phase_prologue(const Params& p, unsigned char* lds) {
    const int tid = my_tid();
    float* tile = (float*)lds;
    if (my_bid() == 0 && tid < 64) ((unsigned*)(p.ws + WS_CTRL))[tid] = 0u;
    constexpr int T_IN = 16 * 56, T_OUT = 16 * 16, T_UP = 16 * 88, T_DN = 44 * 16, T_L = T_IN + T_OUT + T_UP + T_DN;
    constexpr int N_T = 2 * T_L, N_MOD = 2 * 96, N_WSC = 24, N_ALL = N_T + N_MOD + N_WSC;
    {
        struct TD { const float* src; bf16_t* dst; int ldsrc, ldd; };
        auto tdesc = [&](int it) -> TD {
            const int l = it / T_L; int r = it % T_L;
            if (r < T_IN) { const int kt = r / 56, nt = r % 56, d0 = nt * 64; const int s0 = d0 < 1536 ? d0 : (d0 < 3072 ? d0 + 4 : d0 + 12);
                return TD{p.in[I_WIN] + (size_t)l * DM * DIN + (size_t)(kt * 64) * DIN + s0, (bf16_t*)(p.ws + WS_WTIN) + (size_t)l * NPROJ * DM + (size_t)d0 * DM + kt * 64, DIN, DM}; }
            if ((r -= T_IN) < T_OUT) { const int kt = r / 16, nt = r % 16;
                return TD{p.in[I_WOUT] + (size_t)l * DM * DM + (size_t)(kt * 64) * DM + nt * 64, (bf16_t*)(p.ws + WS_WTOUT) + (size_t)l * DM * DM + (size_t)(nt * 64) * DM + kt * 64, DM, DM}; }
            if ((r -= T_OUT) < T_UP) { const int kt = r / 88, nt = r % 88; const int d0 = nt * 64, pn = d0 >> 8, w = d0 & 255, s0 = w < 128 ? pn * 128 + w : DFF + pn * 128 + (w - 128);
                return TD{p.in[I_WUP] + (size_t)l * DM * NUP + (size_t)(kt * 64) * NUP + s0, (bf16_t*)(p.ws + WS_WTUP) + (size_t)l * NUP * DM + (size_t)d0 * DM + kt * 64, NUP, DM}; }
            r -= T_UP; const int kt = r / 16, nt = r % 16;
            return TD{p.in[I_WDN] + (size_t)l * DFF * DM + (size_t)(kt * 64) * DM + nt * 64, (bf16_t*)(p.ws + WS_WTDN) + (size_t)l * DM * DFF + (size_t)(nt * 64) * DFF + kt * 64, DM, DFF};
        };
        const int kk0 = tid >> 4, n4 = (tid & 15) * 4;
        const int nn = tid >> 3, k8 = (tid & 7) * 8;
        int it = my_bid(); TD d{nullptr, nullptr, 0, 0}; f32x4 v0 = (f32x4){0.f, 0.f, 0.f, 0.f}, v1 = v0;
        if (it < N_T) { d = tdesc(it); v0 = *(const f32x4*)(d.src + (size_t)kk0 * d.ldsrc + n4); v1 = *(const f32x4*)(d.src + (size_t)(kk0 + 32) * d.ldsrc + n4); }
        while (it < N_T) {
            const int itn = it + my_gdim(); TD dn{nullptr, nullptr, 0, 0}; f32x4 w0 = (f32x4){0.f, 0.f, 0.f, 0.f}, w1 = w0;
            if (itn < N_T) { dn = tdesc(itn); w0 = *(const f32x4*)(dn.src + (size_t)kk0 * dn.ldsrc + n4); w1 = *(const f32x4*)(dn.src + (size_t)(kk0 + 32) * dn.ldsrc + n4); }
            tile[kk0 * 65 + n4] = v0[0]; tile[kk0 * 65 + n4 + 1] = v0[1]; tile[kk0 * 65 + n4 + 2] = v0[2]; tile[kk0 * 65 + n4 + 3] = v0[3];
            tile[(kk0 + 32) * 65 + n4] = v1[0]; tile[(kk0 + 32) * 65 + n4 + 1] = v1[1]; tile[(kk0 + 32) * 65 + n4 + 2] = v1[2]; tile[(kk0 + 32) * 65 + n4 + 3] = v1[3];
            __syncthreads();
            u32x4 w;
            w.x = pack2(tile[(k8 + 0) * 65 + nn], tile[(k8 + 1) * 65 + nn]); w.y = pack2(tile[(k8 + 2) * 65 + nn], tile[(k8 + 3) * 65 + nn]);
            w.z = pack2(tile[(k8 + 4) * 65 + nn], tile[(k8 + 5) * 65 + nn]); w.w = pack2(tile[(k8 + 6) * 65 + nn], tile[(k8 + 7) * 65 + nn]);
            *(u32x4*)(d.dst + (size_t)nn * d.ldd + k8) = w;
            __syncthreads();
            it = itn; d = dn; v0 = w0; v1 = w1;
        }
    }
    for (int it = my_bid(); it < N_ALL; it += my_gdim()) {
        if (it < N_T) {
            continue;
        } else if (it < N_T + N_MOD) {
            const int r = it - N_T, l = r / 96, n0 = (r % 96) * 64, kg = tid >> 4, c4 = (tid & 15) * 4;
            const float* aw = p.in[I_ADAW] + (size_t)l * DM * 6144 + n0 + c4; const float* cc = p.in[I_C];
            f32x4 ac[4];
#pragma unroll
            for (int b = 0; b < 4; ++b) ac[b] = (f32x4){0.f, 0.f, 0.f, 0.f};
            for (int k0 = kg; k0 < DM; k0 += 256) {
                f32x4 wv[8]; float cv[4][8];
#pragma unroll
                for (int u = 0; u < 8; ++u) wv[u] = *(const f32x4*)(aw + (size_t)(k0 + 32 * u) * 6144);
#pragma unroll
                for (int b = 0; b < 4; ++b)
#pragma unroll
                    for (int u = 0; u < 8; ++u) cv[b][u] = cc[b * DM + k0 + 32 * u];
#pragma unroll
                for (int u = 0; u < 8; ++u)
#pragma unroll
                    for (int b = 0; b < 4; ++b) ac[b] += wv[u] * silu_f(cv[b][u]);
            }
            float* red = tile;
#pragma unroll
            for (int b = 0; b < 4; ++b) *(f32x4*)(red + (kg * 4 + b) * 64 + c4) = ac[b];
            __syncthreads();
            if (tid < 256) { const int b = tid >> 6, col = tid & 63; float s = 0.f;
#pragma unroll
                for (int g = 0; g < 32; ++g) s += red[(g * 4 + b) * 64 + col];
                ((float*)(p.ws + WS_MOD))[((size_t)l * 4 + b) * 6144 + n0 + col] = s + p.in[I_ADAB][(size_t)l * 6144 + n0 + col]; }
            __syncthreads();
        } else {
            const int r = it - N_T - N_MOD, l = r / 12, j = r % 12; const int sc = j < 4 ? 1536 + j : (j < 8 ? 3076 + (j - 4) : 3080 + (j - 8));
            float* dst = (float*)(p.ws + WS_WSC) + ((size_t)l * 12 + j) * DM; const float* src = p.in[I_WIN] + (size_t)l * DM * DIN + sc;
            for (int k = tid; k < DM; k += NTHR) dst[k] = src[(size_t)k * DIN];
        }
    }
}

__device__ __forceinline__ void phase_norm(const Params& p, unsigned char* lds, const float* __restrict__ xin, const float* g, const float* mod  , int shift_off, int scale_off, bf16_t* __restrict__ hout, const float* wsc  , float* scal) {
    const int tid = my_tid(), wid = tid >> 6, lane = tid & 63;
    float* wl = (float*)lds;
    if (wsc) { for (int i = tid; i < 12 * DM; i += NTHR) wl[i] = wsc[i]; __syncthreads(); }
    const int gw = my_bid() * 8 + wid, nw = my_gdim() * 8;
    for (int rb = gw * 4; rb < MTOK; rb += nw * 4) {
        const int b = rb >> 13;
        float cs[16], sh[16];
#pragma unroll
        for (int i = 0; i < 2; ++i)
#pragma unroll
            for (int j = 0; j < 8; ++j) { const int k = i * 512 + lane * 8 + j; cs[i * 8 + j] = g[k] * (1.0f + mod[(size_t)b * 6144 + scale_off + k]); sh[i * 8 + j] = mod[(size_t)b * 6144 + shift_off + k]; }
        { const int r4 = 0;
            f32x4 xq[4][4];
#pragma unroll
            for (int q = 0; q < 4; ++q) { const float* xp = xin + (size_t)(rb + r4 + q) * DM + lane * 8;
                xq[q][0] = __builtin_nontemporal_load((const f32x4*)xp); xq[q][1] = __builtin_nontemporal_load((const f32x4*)(xp + 4)); xq[q][2] = __builtin_nontemporal_load((const f32x4*)(xp + 512)); xq[q][3] = __builtin_nontemporal_load((const f32x4*)(xp + 516)); }
#pragma unroll
            for (int q = 0; q < 4; ++q) {
            const int row = rb + r4 + q;
            const f32x4 x0 = xq[q][0], x1 = xq[q][1], x2 = xq[q][2], x3 = xq[q][3];
            float xv[16] = {x0[0], x0[1], x0[2], x0[3], x1[0], x1[1], x1[2], x1[3], x2[0], x2[1], x2[2], x2[3], x3[0], x3[1], x3[2], x3[3]};
            float ss = 0.f;
#pragma unroll
            for (int i = 0; i < 16; ++i) ss += xv[i] * xv[i];
            ss = wave_sum(ss);
            const float rstd = rsqrtf(ss * (1.0f / DM) + EPS);
            float h[16];
#pragma unroll
            for (int i = 0; i < 16; ++i) h[i] = xv[i] * rstd * cs[i] + sh[i];
            u32x4 w0, w1;
            w0.x = pack2(h[0], h[1]); w0.y = pack2(h[2], h[3]); w0.z = pack2(h[4], h[5]); w0.w = pack2(h[6], h[7]);
            w1.x = pack2(h[8], h[9]); w1.y = pack2(h[10], h[11]); w1.z = pack2(h[12], h[13]); w1.w = pack2(h[14], h[15]);
            bf16_t* hp = hout + (size_t)row * DM + lane * 8;
            *(u32x4*)hp = w0; *(u32x4*)(hp + 512) = w1;
            if (wsc) {
                float mine = 0.f;
#pragma unroll
                for (int j = 0; j < 12; ++j) {
                    const float* wj = wl + j * DM + lane * 8;
                    const f32x4 a0 = *(const f32x4*)wj, a1 = *(const f32x4*)(wj + 4), a2 = *(const f32x4*)(wj + 512), a3 = *(const f32x4*)(wj + 516);
                    float s = h[0] * a0[0] + h[1] * a0[1] + h[2] * a0[2] + h[3] * a0[3] + h[4] * a1[0] + h[5] * a1[1] + h[6] * a1[2] + h[7] * a1[3]
                            + h[8] * a2[0] + h[9] * a2[1] + h[10] * a2[2] + h[11] * a2[3] + h[12] * a3[0] + h[13] * a3[1] + h[14] * a3[2] + h[15] * a3[3];
                    s = wave_sum(s);
                    mine = (lane == j) ? s : mine;
                }
                if (lane < 12) scal[(size_t)row * 16 + lane] = mine;
            }
            }
        }
    }
}

__device__ void phase_final_norm(const float* xin, const float* g, float* out) {
    const int tid = my_tid(), wid = tid >> 6, lane = tid & 63;
    const int gw = my_bid() * 8 + wid, nw = my_gdim() * 8;
    f32x4 gv[4];
#pragma unroll
    for (int i = 0; i < 4; ++i) gv[i] = *(const f32x4*)(g + i * 256 + lane * 4);
    for (int rb = gw * 4; rb < MTOK; rb += nw * 4) {
        f32x4 x[4][4];
#pragma unroll
        for (int q = 0; q < 4; ++q)
#pragma unroll
            for (int i = 0; i < 4; ++i) x[q][i] = __builtin_nontemporal_load((const f32x4*)(xin + (size_t)(rb + q) * DM + i * 256 + lane * 4));
#pragma unroll
        for (int q = 0; q < 4; ++q) { float ss = 0.f;
#pragma unroll
            for (int i = 0; i < 4; ++i) ss += (x[q][i][0] * x[q][i][0] + x[q][i][1] * x[q][i][1]) + (x[q][i][2] * x[q][i][2] + x[q][i][3] * x[q][i][3]);
            ss = wave_sum(ss);
            const float rstd = rsqrtf(ss * (1.0f / DM) + EPS);
#pragma unroll
            for (int i = 0; i < 4; ++i) __builtin_nontemporal_store(x[q][i] * rstd * gv[i], (f32x4*)(out + (size_t)(rb + q) * DM + i * 256 + lane * 4)); }
    }
}

__device__ void phase_finalize(const unsigned char* __restrict__ prep, const bf16_t* __restrict__ pz, const float* gn, bf16_t* __restrict__ mix) {
    const int tid = my_tid(), wid = tid >> 6, lane = tid & 63;
    const int gw = my_bid() * 8 + wid, nw = my_gdim() * 8;
    const int hh = lane >> 4, d0 = (lane & 15) * 8;
    float gv[8];
#pragma unroll
    for (int j = 0; j < 8; ++j) gv[j] = gn[d0 + j];
    for (int rb = gw * 4; rb < MTOK; rb += nw * 4) {
        u32x4 oq[4], zq[4];
#pragma unroll
        for (int q = 0; q < 4; ++q) { const int row = rb + q, b = row >> 13, t = row & (SEQ - 1), n = t >> 6, c = t & 63;
            oq[q] = __builtin_nontemporal_load((const u32x4*)(prep + (size_t)(((b * 4 + hh) * 128) + n) * PREP_UNIT + 57344 + (d0 >> 6) * 8192 + (c * 64 + (d0 & 63)) * 2));
            zq[q] = __builtin_nontemporal_load((const u32x4*)(pz + (size_t)row * 512 + lane * 8)); }
#pragma unroll
        for (int q = 0; q < 4; ++q) { const int row = rb + q;
            float ov[8]; unpack8(oq[q], ov);
            float ss = 0.f;
#pragma unroll
            for (int j = 0; j < 8; ++j) ss += ov[j] * ov[j];
            ss += __shfl_xor(ss, 1); ss += __shfl_xor(ss, 2); ss += __shfl_xor(ss, 4); ss += __shfl_xor(ss, 8);
            const float rstd = rsqrtf(ss * (1.0f / 128.0f) + EPS);
            float zf[8]; unpack8(zq[q], zf);
            float r[8];
#pragma unroll
            for (int j = 0; j < 8; ++j) r[j] = ov[j] * rstd * gv[j] * silu_f(zf[j]);
            u32x4 w; w.x = pack2(r[0], r[1]); w.y = pack2(r[2], r[3]); w.z = pack2(r[4], r[5]); w.w = pack2(r[6], r[7]);
            *(u32x4*)(mix + (size_t)row * DM + 512 + lane * 8) = w; }
    }
}

__device__ void fix_panel(const float* halo, const float* cw  , bf16_t* act, int pm) {
    const int t = my_tid();
    if (t < 22 * 16) {
        const int c = (t & 15) * 8, pn = t >> 4, j = pn * 128 + c;
        const float* ht = halo + (size_t)(pm * 22 + pn) * 1024 + c;
        const bool first = ((pm * 256) & (SEQ - 1)) == 0;
        const float* hp = halo + (size_t)((first ? pm : pm - 1) * 22 + pn) * 1024 + c;
        float a0[8], a1[8];
#pragma unroll
        for (int q = 0; q < 2; ++q) {
            const f32x4 z4 = (f32x4){0.f, 0.f, 0.f, 0.f};
            const f32x4 g0 = *(const f32x4*)(ht + 4 * q), g1 = *(const f32x4*)(ht + 256 + 4 * q), u0 = *(const f32x4*)(ht + 128 + 4 * q), u1 = *(const f32x4*)(ht + 384 + 4 * q);
            const f32x4 gb0 = first ? z4 : *(const f32x4*)(hp + 512 + 4 * q), gb1 = first ? z4 : *(const f32x4*)(hp + 768 + 4 * q);
            const f32x4 ub0 = first ? z4 : *(const f32x4*)(hp + 640 + 4 * q), ub1 = first ? z4 : *(const f32x4*)(hp + 896 + 4 * q);
            const f32x4 wg0 = *(const f32x4*)(cw + j + 4 * q), wg1 = *(const f32x4*)(cw + NUP + j + 4 * q), wg2 = *(const f32x4*)(cw + 2 * NUP + j + 4 * q);
            const f32x4 wu0 = *(const f32x4*)(cw + DFF + j + 4 * q), wu1 = *(const f32x4*)(cw + NUP + DFF + j + 4 * q), wu2 = *(const f32x4*)(cw + 2 * NUP + DFF + j + 4 * q);
#pragma unroll
            for (int e = 0; e < 4; ++e) {
                a0[4 * q + e] = silu_f(wg0[e] * gb0[e] + wg1[e] * gb1[e] + wg2[e] * g0[e]) * (wu0[e] * ub0[e] + wu1[e] * ub1[e] + wu2[e] * u0[e]);
                a1[4 * q + e] = silu_f(wg0[e] * gb1[e] + wg1[e] * g0[e] + wg2[e] * g1[e]) * (wu0[e] * ub1[e] + wu1[e] * u0[e] + wu2[e] * u1[e]); }
        }
        u32x4 w0, w1;
        w0.x = pack2(a0[0], a0[1]); w0.y = pack2(a0[2], a0[3]); w0.z = pack2(a0[4], a0[5]); w0.w = pack2(a0[6], a0[7]);
        w1.x = pack2(a1[0], a1[1]); w1.y = pack2(a1[2], a1[3]); w1.z = pack2(a1[4], a1[5]); w1.w = pack2(a1[6], a1[7]);
        *(u32x4*)(act + (size_t)(pm * 256) * DFF + j) = w0;
        *(u32x4*)(act + (size_t)(pm * 256 + 1) * DFF + j) = w1;
    }
}
__device__ void phase_fixup(const float* halo, const float* cw  , bf16_t* act) {
    const int gt = my_bid() * NTHR + my_tid(), stride = my_gdim() * NTHR;
    for (int task = gt; task < 128 * 22 * 16; task += stride) {
        const int c = (task & 15) * 8, pn = (task >> 4) % 22, pm = (task >> 4) / 22, j = pn * 128 + c;
        const float* ht = halo + (size_t)(pm * 22 + pn) * 1024 + c;
        const bool first = ((pm * 256) & (SEQ - 1)) == 0;
        const float* hp = halo + (size_t)((first ? pm : pm - 1) * 22 + pn) * 1024 + c;
        float a0[8], a1[8];
#pragma unroll
        for (int q = 0; q < 2; ++q) {
            const f32x4 z4 = (f32x4){0.f, 0.f, 0.f, 0.f};
            const f32x4 g0 = *(const f32x4*)(ht + 4 * q), g1 = *(const f32x4*)(ht + 256 + 4 * q), u0 = *(const f32x4*)(ht + 128 + 4 * q), u1 = *(const f32x4*)(ht + 384 + 4 * q);
            const f32x4 gb0 = first ? z4 : *(const f32x4*)(hp + 512 + 4 * q), gb1 = first ? z4 : *(const f32x4*)(hp + 768 + 4 * q);
            const f32x4 ub0 = first ? z4 : *(const f32x4*)(hp + 640 + 4 * q), ub1 = first ? z4 : *(const f32x4*)(hp + 896 + 4 * q);
            const f32x4 wg0 = *(const f32x4*)(cw + j + 4 * q), wg1 = *(const f32x4*)(cw + NUP + j + 4 * q), wg2 = *(const f32x4*)(cw + 2 * NUP + j + 4 * q);
            const f32x4 wu0 = *(const f32x4*)(cw + DFF + j + 4 * q), wu1 = *(const f32x4*)(cw + NUP + DFF + j + 4 * q), wu2 = *(const f32x4*)(cw + 2 * NUP + DFF + j + 4 * q);
#pragma unroll
            for (int e = 0; e < 4; ++e) {
                a0[4 * q + e] = silu_f(wg0[e] * gb0[e] + wg1[e] * gb1[e] + wg2[e] * g0[e]) * (wu0[e] * ub0[e] + wu1[e] * ub1[e] + wu2[e] * u0[e]);
                a1[4 * q + e] = silu_f(wg0[e] * gb1[e] + wg1[e] * g0[e] + wg2[e] * g1[e]) * (wu0[e] * ub1[e] + wu1[e] * u0[e] + wu2[e] * u1[e]); }
        }
        u32x4 w0, w1;
        w0.x = pack2(a0[0], a0[1]); w0.y = pack2(a0[2], a0[3]); w0.z = pack2(a0[4], a0[5]); w0.w = pack2(a0[6], a0[7]);
        w1.x = pack2(a1[0], a1[1]); w1.y = pack2(a1[2], a1[3]); w1.z = pack2(a1[4], a1[5]); w1.w = pack2(a1[6], a1[7]);
        *(u32x4*)(act + (size_t)(pm * 256) * DFF + j) = w0;
        *(u32x4*)(act + (size_t)(pm * 256 + 1) * DFF + j) = w1;
    }
}

__device__ void fcum_unit(unsigned char* lds, int bh, const float* scal, const float* fgb  , float* F, const bf16_t* kp  , float* knsuf  , const bf16_t* kpa  , const float* relh  , float* ab  , unsigned* flag, unsigned fval) {
    const int tid = my_tid(), wid = tid >> 6, lane = tid & 63, b = bh >> 2, h = bh & 3;
    float* wt = (float*)lds;
    const float fb = fgb[h];
    float v[16]; float run = 0.f;
#pragma unroll
    for (int i = 0; i < 16; ++i) { const float x = scal[((size_t)b * SEQ + tid * 16 + i) * 16 + h] + fb; run += fminf(x, 0.f) - log1pf(__expf(-fabsf(x))); v[i] = run; }
    float inc = run;
#pragma unroll
    for (int o = 1; o < 64; o <<= 1) { const float y = __shfl_up(inc, o); if (lane >= o) inc += y; }
    if (lane == 63) wt[wid] = inc;
    __syncthreads();
    float off = inc - run;
    for (int w = 0; w < wid; ++w) off += wt[w];
#pragma unroll
    for (int i = 0; i < 16; ++i) F[(size_t)bh * SEQ + tid * 16 + i] = v[i] + off;
    float* km = (float*)(lds + 1024);
    for (int t = wid; t < 128; t += 8) {
        const bf16_t* kr = kp + (size_t)(t * 64 + lane) * 1536; float ss = 0.f;
#pragma unroll
        for (int q = 0; q < 8; ++q) { float f[8]; unpack8(*(const u32x4*)(kr + 8 * q), f);
#pragma unroll
            for (int j = 0; j < 8; ++j) ss += f[j] * f[j]; }
        float m = sqrtf(ss);
#pragma unroll
        for (int o = 32; o > 0; o >>= 1) m = fmaxf(m, __shfl_xor(m, o));
        if (lane == 0) km[t] = m;
    }
    __syncthreads();
    if (tid < 128) { float m = 0.f; for (int t = 0; t <= tid; ++t) m = fmaxf(m, km[t]); knsuf[tid] = m; }
    { float* km2 = (float*)(lds + 2048); float mw = 0.f;
      for (int t = wid; t < 128; t += 8) {
          const bf16_t* kr = kpa + (size_t)(t * 64 + lane) * 1536; float ss = 0.f;
#pragma unroll
          for (int q = 0; q < 8; ++q) { float f[8]; unpack8(*(const u32x4*)(kr + 8 * q), f);
#pragma unroll
              for (int j = 0; j < 8; ++j) ss += f[j] * f[j]; }
          mw = fmaxf(mw, sqrtf(ss)); }
#pragma unroll
      for (int o = 32; o > 0; o >>= 1) mw = fmaxf(mw, __shfl_xor(mw, o));
      float bm = -1e30f;
      for (int i = tid; i < 320; i += NTHR) bm = fmaxf(bm, relh[i] * LOG2E);
#pragma unroll
      for (int o = 32; o > 0; o >>= 1) bm = fmaxf(bm, __shfl_xor(bm, o));
      if (lane == 0) { km2[wid] = mw; km2[8 + wid] = bm; }
      __syncthreads();
      if (tid == 0) { float a = 0.f, c = -1e30f; for (int w = 0; w < 8; ++w) { a = fmaxf(a, km2[w]); c = fmaxf(c, km2[8 + w]); } ab[0] = a * 1.0001f; ab[1] = c; }
    }
    handoff_publish(flag, fval);
    __syncthreads();
}

__device__ __forceinline__ void split_bf16(const float* x, bf16x8& hi, bf16x8& lo) {
    u32x4 h, l;
#pragma unroll
    for (int i = 0; i < 4; ++i) {
        const unsigned ph = pack2(x[2 * i], x[2 * i + 1]);
        const float r0 = x[2 * i] - __uint_as_float(ph << 16), r1 = x[2 * i + 1] - __uint_as_float(ph & 0xffff0000u);
        h[i] = ph; l[i] = pack2(r0, r1);
    }
    hi = __builtin_bit_cast(bf16x8, h); lo = __builtin_bit_cast(bf16x8, l);
}
__device__ void prep_unit(unsigned char* lds, int bh, int n, const bf16_t* pc, const float* scal, const float* convw  , float alog, float dtb, unsigned char* unit, float* egl, unsigned* flag, unsigned fval) {
    const int tid = my_tid(), wid = tid >> 6, lane = tid & 63, b = bh >> 2, h = bh & 3;
    float* qT = (float*)lds; float* kT = (float*)(lds + 34816); float* vT = (float*)(lds + 69632);
    float* Am = (float*)(lds + 104448); float* At = (float*)(lds + 121856);
    float* gc = (float*)(lds + 139264); float* bet = gc + 64; float* rq = gc + 128; float* rk = gc + 192;
    bf16_t* stage = (bf16_t*)(lds + 140288); float* ssp = (float*)(lds + 140288);
    const size_t row0 = (size_t)b * SEQ + (size_t)n * 64;
    const __amdgpu_buffer_rsrc_t ur = __builtin_amdgcn_make_buffer_rsrc(unit, 0, PREP_UNIT, 0x00020000);
#ifndef REP_S1
#define REP_S1 1
#endif
    for (int rep1 = 0; rep1 < REP_S1; ++rep1) {
    if (tid < 384) {
        const int part = tid >> 7, cg8 = (tid & 127) >> 3, run = tid & 7, col = part * 512 + h * 128 + cg8 * 8;
        float w[4][8];
#pragma unroll
        for (int i = 0; i < 4; ++i) { const f32x4 w0 = *(const f32x4*)(convw + i * 1536 + col), w1 = *(const f32x4*)(convw + i * 1536 + col + 4);
#pragma unroll
            for (int j = 0; j < 4; ++j) { w[i][j] = w0[j]; w[i][4 + j] = w1[j]; } }
        u32x4 xr[11];
#pragma unroll
        for (int i = 0; i < 11; ++i) { const int tl = run * 8 - 3 + i; const bool ok = (n > 0) || (tl >= 0);
            xr[i] = ok ? __builtin_nontemporal_load((const u32x4*)(pc + (row0 + tl) * 1536 + col)) : (u32x4){0u, 0u, 0u, 0u}; }
        float y[8][8];
#pragma unroll
        for (int t = 0; t < 8; ++t)
#pragma unroll
            for (int j = 0; j < 8; ++j) y[t][j] = 0.f;
#pragma unroll
        for (int i = 0; i < 11; ++i) { float xf[8]; unpack8(xr[i], xf);
#pragma unroll
            for (int t = 0; t < 8; ++t) { const int wi = i - t; if (wi >= 0 && wi < 4) {
#pragma unroll
                for (int j = 0; j < 8; ++j) y[t][j] += w[wi][j] * xf[j]; } } }
        float* XT = part == 0 ? qT : (part == 1 ? kT : vT);
        float sq[8];
#pragma unroll
        for (int t = 0; t < 8; ++t) sq[t] = 0.f;
#pragma unroll
        for (int j = 0; j < 8; ++j) {
#pragma unroll
            for (int t = 0; t < 8; ++t) { y[t][j] = silu_f(y[t][j]); sq[t] += y[t][j] * y[t][j]; }
            f32x4 a, c;
            a[0] = y[0][j]; a[1] = y[1][j]; a[2] = y[2][j]; a[3] = y[3][j]; c[0] = y[4][j]; c[1] = y[5][j]; c[2] = y[6][j]; c[3] = y[7][j];
            *(f32x4*)(XT + (cg8 * 8 + j) * 68 + run * 8) = a; *(f32x4*)(XT + (cg8 * 8 + j) * 68 + run * 8 + 4) = c;
        }
        if (part < 2) {
#pragma unroll
            for (int t = 0; t < 8; ++t) { float v = sq[t]; v += __shfl_xor(v, 8); v += __shfl_xor(v, 16); v += __shfl_xor(v, 32); sq[t] = v; }
            if ((lane >> 3) == 0) {
#pragma unroll
                for (int t = 0; t < 8; ++t) ssp[(part * 2 + (wid & 1)) * 64 + run * 8 + t] = sq[t];
            }
        }
    } else if (tid < 448) {
        const int t = tid - 384; const float* sp = scal + (row0 + t) * 16;
        bet[t] = 1.0f / (1.0f + __expf(-sp[4 + h]));
        gc[t] = -__expf(alog) * softplus_f(sp[8 + h] + dtb);
    }
    __syncthreads();
    }
    if (tid < 64) rq[tid] = rsqrtf(ssp[tid] + ssp[64 + tid] + EPS) * 0.08838834764831845f;
    else if (tid < 128) rk[tid - 64] = rsqrtf(ssp[128 + tid - 64] + ssp[192 + tid - 64] + EPS);
    else if (tid < 192) { float v = gc[lane];
#pragma unroll
        for (int o = 1; o < 64; o <<= 1) { const float y = __shfl_up(v, o); if (lane >= o) v += y; }
        gc[lane] = v; }
    __syncthreads();
#ifndef REP_S3
#define REP_S3 1
#endif
    for (int rep3 = 0; rep3 < REP_S3; ++rep3) {
    {
        const int rb = wid & 3, quad = lane >> 4, cl = lane & 15; const bool isq = wid >= 4;
        const float* XT = isq ? qT : kT; float* Out = isq ? At : Am; const float* rX = isq ? rq : rk;
        bf16x8 ah[4], al[4];
#pragma unroll
        for (int ks = 0; ks < 4; ++ks) { float x[8];
#pragma unroll
            for (int jj = 0; jj < 8; ++jj) x[jj] = XT[(32 * ks + 16 * (jj >> 2) + 4 * quad + (jj & 3)) * 68 + 16 * rb + cl];
            split_bf16(x, ah[ks], al[ks]); }
        float gi[4], si[4];
#pragma unroll
        for (int j = 0; j < 4; ++j) { const int i = 16 * rb + quad * 4 + j; gi[j] = gc[i]; si[j] = rX[i] * (isq ? 1.0f : bet[i]); }
        for (int cb = 0; cb < 4; ++cb) {
            const int jc = 16 * cb + cl;
            if (cb <= rb) {
                f32x4 acc = (f32x4){0.f, 0.f, 0.f, 0.f};
#pragma unroll
                for (int ks = 0; ks < 4; ++ks) { float x[8]; bf16x8 bh_, bl_;
#pragma unroll
                    for (int jj = 0; jj < 8; ++jj) x[jj] = kT[(32 * ks + 16 * (jj >> 2) + 4 * quad + (jj & 3)) * 68 + jc];
                    split_bf16(x, bh_, bl_);
                    acc = MFMA16(ah[ks], bh_, acc); acc = MFMA16(ah[ks], bl_, acc); acc = MFMA16(al[ks], bh_, acc); }
                const float gj = gc[jc], sj = rk[jc];
#pragma unroll
                for (int j = 0; j < 4; ++j) { const int i = 16 * rb + quad * 4 + j; const bool keep = isq ? (i >= jc) : (i > jc);
                    Out[i * 68 + jc] = keep ? acc[j] * si[j] * sj * __expf(fminf(gi[j] - gj, 0.f)) : 0.f; }
            } else {
#pragma unroll
                for (int j = 0; j < 4; ++j) Out[(16 * rb + quad * 4 + j) * 68 + jc] = 0.f;
            }
        }
    }
    __syncthreads();
    }
    if (wid == 0) {
        const int c = lane;
        int zv = 0; asm volatile("" : "+v"(zv)); const float* AmV = Am + zv;
        for (int rb = 0; rb < 4; ++rb) {
            typedef float f32x2v __attribute__((ext_vector_type(2)));
            f32x2v sp[8];
#pragma unroll
            for (int q = 0; q < 8; ++q) { sp[q][0] = (16 * rb + 2 * q == c) ? 1.0f : 0.0f; sp[q][1] = (16 * rb + 2 * q + 1 == c) ? 1.0f : 0.0f; }
            for (int j4 = 0; j4 < 4 * rb; ++j4) {
                const float t0 = Am[(4 * j4 + 0) * 68 + c], t1 = Am[(4 * j4 + 1) * 68 + c], t2 = Am[(4 * j4 + 2) * 68 + c], t3 = Am[(4 * j4 + 3) * 68 + c];
                const f32x2v T0 = {t0, t0}, T1 = {t1, t1}, T2 = {t2, t2}, T3 = {t3, t3};
#pragma unroll
                for (int q = 0; q < 8; ++q) { const f32x4 a4 = *(const f32x4*)(AmV + (16 * rb + 2 * q) * 68 + 4 * j4), b4 = *(const f32x4*)(AmV + (16 * rb + 2 * q + 1) * 68 + 4 * j4);
                    f32x2v acc2 = sp[q];
                    acc2 -= (f32x2v){a4[0], b4[0]} * T0; acc2 -= (f32x2v){a4[1], b4[1]} * T1; acc2 -= (f32x2v){a4[2], b4[2]} * T2; acc2 -= (f32x2v){a4[3], b4[3]} * T3;
                    sp[q] = acc2; }
            }
            float sx[16];
#pragma unroll
            for (int r = 0; r < 16; ++r) sx[r] = sp[r >> 1][r & 1];
#pragma unroll
            for (int r = 1; r < 16; ++r) {
#pragma unroll
                for (int q4 = 0; q4 < (r + 3) / 4; ++q4) { const f32x4 a4 = *(const f32x4*)(AmV + (16 * rb + r) * 68 + 16 * rb + 4 * q4);
#pragma unroll
                    for (int jj = 0; jj < 4; ++jj) if (4 * q4 + jj < r) sx[r] -= a4[jj] * sx[4 * q4 + jj]; }
            }
            bf16_t* sf = stage + (rb * 2 + (c >> 5)) * 512 + ((c >> 3) & 3) * 128 + (c & 7);
#pragma unroll
            for (int r = 0; r < 16; r += 2) {
                Am[(16 * rb + r) * 68 + c] = sx[r]; Am[(16 * rb + r + 1) * 68 + c] = sx[r + 1];
                const unsigned ph = pack2(sx[r], sx[r + 1]);
                const unsigned pl = pack2(sx[r] - __uint_as_float(ph << 16), sx[r + 1] - __uint_as_float(ph & 0xffff0000u));
                sf[r * 8] = (bf16_t)(ph & 0xffffu); sf[(r + 1) * 8] = (bf16_t)(ph >> 16);
                sf[4096 + r * 8] = (bf16_t)(pl & 0xffffu); sf[4096 + (r + 1) * 8] = (bf16_t)(pl >> 16);
            }
        }
    } else if (tid >= 256) {
        const int u = tid - 256; const float glast = gc[63];
#pragma unroll
        for (int it = 0; it < 4; ++it) {
            const int q = u + 256 * it, f = q >> 6, L = q & 63, mt = f >> 2, ks = f & 3, quad = L >> 4, r = L & 15, i_ = 16 * mt + r;
            const float eg = __expf(gc[i_]) * rq[i_]; float v[8];
#pragma unroll
            for (int jj = 0; jj < 8; ++jj) { const int kd = 32 * ks + 16 * (jj >> 2) + 4 * quad + (jj & 3); v[jj] = qT[kd * 68 + i_] * eg; }
            u32x4 w; w.x = pack2(v[0], v[1]); w.y = pack2(v[2], v[3]); w.z = pack2(v[4], v[5]); w.w = pack2(v[6], v[7]);
            __builtin_amdgcn_raw_buffer_store_b128(w, ur, 16384 + q * 16, 0, 16);
        }
#pragma unroll
        for (int it = 0; it < 4; ++it) {
            const int q = u + 256 * it, f = q >> 6, L = q & 63, mt = f >> 1, ks = f & 1, quad = L >> 4, r = L & 15, kd = 16 * mt + r;
            float v[8];
#pragma unroll
            for (int hh = 0; hh < 2; ++hh) { const int c0 = 32 * ks + 16 * hh + 4 * quad; const f32x4 kk = *(const f32x4*)(kT + kd * 68 + c0), gg = *(const f32x4*)(gc + c0), rr = *(const f32x4*)(rk + c0);
#pragma unroll
                for (int j = 0; j < 4; ++j) v[hh * 4 + j] = kk[j] * rr[j] * __expf(glast - gg[j]); }
            u32x4 w; w.x = pack2(v[0], v[1]); w.y = pack2(v[2], v[3]); w.z = pack2(v[4], v[5]); w.w = pack2(v[6], v[7]);
            __builtin_amdgcn_raw_buffer_store_b128(w, ur, 32768 + q * 16, 0, 16);
        }
#pragma unroll
        for (int it = 0; it < 2; ++it) {
            const int q = u + 256 * it, f = q >> 6, L = q & 63, mt = f >> 1, ks = f & 1, quad = L >> 4, r = L & 15, i_ = 16 * mt + r;
            const f32x4 a0 = *(const f32x4*)(At + i_ * 68 + 32 * ks + 4 * quad), a1 = *(const f32x4*)(At + i_ * 68 + 32 * ks + 16 + 4 * quad);
            u32x4 w; w.x = pack2(a0[0], a0[1]); w.y = pack2(a0[2], a0[3]); w.z = pack2(a1[0], a1[1]); w.w = pack2(a1[2], a1[3]);
            __builtin_amdgcn_raw_buffer_store_b128(w, ur, 49152 + q * 16, 0, 16);
        }
        if (u == 0) __hip_atomic_store(egl + bh * 128 + n, __expf(glast), __ATOMIC_RELAXED, __HIP_MEMORY_SCOPE_AGENT);
    }
    __syncthreads();
    f32x4 uw[2][4];
    {
        const int quad = lane >> 4, cl = lane & 15;
        bf16x8 th[4][2], tl[4][2];
#pragma unroll
        for (int mt = 0; mt < 4; ++mt)
#pragma unroll
            for (int ks = 0; ks < 2; ++ks) { th[mt][ks] = *(const bf16x8*)((const unsigned char*)stage + ((mt * 2 + ks) * 512 + lane * 8) * 2); tl[mt][ks] = *(const bf16x8*)((const unsigned char*)stage + 8192 + ((mt * 2 + ks) * 512 + lane * 8) * 2); }
#pragma unroll
        for (int nt = 0; nt < 2; ++nt) {
            const int col = 32 * wid + 16 * nt + cl; const float* src = col < 128 ? vT + col * 68 : kT + (col - 128) * 68;
            bf16x8 bh_[2], bl_[2];
#pragma unroll
            for (int ks = 0; ks < 2; ++ks) { const int s0 = 32 * ks + quad * 8; float x[8];
                const f32x4 r0 = *(const f32x4*)(src + s0), r1 = *(const f32x4*)(src + s0 + 4), b0 = *(const f32x4*)(bet + s0), b1 = *(const f32x4*)(bet + s0 + 4);
#pragma unroll
                for (int j = 0; j < 4; ++j) { x[j] = r0[j] * b0[j]; x[4 + j] = r1[j] * b1[j]; }
                if (col >= 128) {
#pragma unroll
                    for (int j = 0; j < 8; ++j) x[j] *= rk[s0 + j] * __expf(gc[s0 + j]); }
                split_bf16(x, bh_[ks], bl_[ks]); }
#pragma unroll
            for (int mt = 0; mt < 4; ++mt) { f32x4 acc = (f32x4){0.f, 0.f, 0.f, 0.f};
#pragma unroll
                for (int ks = 0; ks < 2; ++ks) { acc = MFMA16(th[mt][ks], bh_[ks], acc); acc = MFMA16(tl[mt][ks], bh_[ks], acc); acc = MFMA16(th[mt][ks], bl_[ks], acc); }
                uw[nt][mt] = acc; }
        }
        if (wid < 4) {
#pragma unroll
            for (int nt = 0; nt < 2; ++nt)
#pragma unroll
                for (int mt = 0; mt < 4; ++mt) { u32x2 w; w.x = pack2(uw[nt][mt][0], uw[nt][mt][1]); w.y = pack2(uw[nt][mt][2], uw[nt][mt][3]);
                    __builtin_amdgcn_raw_buffer_store_b64(w, ur, 57344 + ((32 * wid + 16 * nt + cl) * 64 + 16 * mt + quad * 4) * 2, 0, 16); }
        }
    }
    __syncthreads();
    if (wid >= 4) {
        const int quad = lane >> 4, cl = lane & 15;
#pragma unroll
        for (int nt = 0; nt < 2; ++nt) { const int kd = 32 * (wid - 4) + 16 * nt + cl, ks = kd >> 5, kd32 = kd & 31, fo = ks * 512 + ((kd32 >> 2) & 3) * 128 + (kd32 >> 4) * 4 + (kd32 & 3);
#pragma unroll
            for (int mt = 0; mt < 4; ++mt) {
                const unsigned p0 = pack2(-uw[nt][mt][0], -uw[nt][mt][1]), p1 = pack2(-uw[nt][mt][2], -uw[nt][mt][3]);
                const int ob = mt * 2048 + fo + (quad * 4) * 8;
                stage[ob] = (bf16_t)(p0 & 0xffffu); stage[ob + 8] = (bf16_t)(p0 >> 16); stage[ob + 16] = (bf16_t)(p1 & 0xffffu); stage[ob + 24] = (bf16_t)(p1 >> 16);
            } }
    }
    __syncthreads();
#pragma unroll
    for (int it = 0; it < 2; ++it) { const int q = tid + NTHR * it; __builtin_amdgcn_raw_buffer_store_b128(*(const u32x4*)((const unsigned char*)stage + q * 16), ur, q * 16, 0, 16); }
    handoff_publish_wt(flag, fval);
}

__device__ __forceinline__ int scan_wait(unsigned char* lds, const unsigned* uflag, int ready, int need, unsigned fval) {
    volatile int* slot = (volatile int*)(lds + LDS_SLOT_C + 4);
    if (threadIdx.x < 64) {
        const int lane = threadIdx.x; int r = ready;
        for (;;) {
            const int idx = r + lane; unsigned v = fval;
            if (idx < 128) v = __hip_atomic_load(uflag + idx, __ATOMIC_RELAXED, __HIP_MEMORY_SCOPE_AGENT);
            const unsigned long long notready = __ballot(v < fval);
            const int cnt = notready ? (int)__builtin_ctzll(notready) : 64;
            r += cnt; if (r > 128) r = 128;
            if (r >= need) break;
            __builtin_amdgcn_s_sleep(8);
        }
        __builtin_amdgcn_fence(__ATOMIC_ACQUIRE, "agent");
        asm volatile("s_waitcnt vmcnt(0)" ::: "memory");
        if (lane == 0) *slot = r;
    }
    __syncthreads();
    const int res = *slot;
    __syncthreads();
    return res;
}
#define SCAN_SB __builtin_amdgcn_sched_barrier(0)
__device__ __forceinline__ void scan_compute(const unsigned char* B, const u32x2* ut, float eg, f32x4* Sacc, bf16x8* Sb, bf16_t* op0, int lane) {
    const unsigned char* Bl = B + lane * 16;
    bf16x8 fx[16], fy[8];
#pragma unroll
    for (int i = 0; i < 16; ++i) fx[i] = *(const bf16x8*)(Bl + i * 1024);
#pragma unroll
    for (int i = 0; i < 8; ++i) fy[i] = *(const bf16x8*)(Bl + 16384 + i * 1024);
    f32x4 vn[4];
#pragma unroll
    for (int mt = 0; mt < 4; ++mt) { vn[mt][0] = __uint_as_float(ut[mt].x << 16); vn[mt][1] = __uint_as_float(ut[mt].x & 0xffff0000u); vn[mt][2] = __uint_as_float(ut[mt].y << 16); vn[mt][3] = __uint_as_float(ut[mt].y & 0xffff0000u); }
    SCAN_SB;
#pragma unroll
    for (int ks = 0; ks < 4; ++ks)
#pragma unroll
        for (int mt = 0; mt < 4; ++mt) vn[mt] = MFMA16(fx[mt * 4 + ks], Sb[ks], vn[mt]);
    SCAN_SB;
#pragma unroll
    for (int i = 0; i < 8; ++i) fx[i] = *(const bf16x8*)(Bl + 16384 + (8 + i) * 1024);
#pragma unroll
    for (int i = 0; i < 8; ++i) fx[8 + i] = *(const bf16x8*)(Bl + 49152 + i * 1024);
    f32x4 oa[4];
#pragma unroll
    for (int mt = 0; mt < 4; ++mt) oa[mt] = (f32x4){0.f, 0.f, 0.f, 0.f};
    SCAN_SB;
#pragma unroll
    for (int ks = 0; ks < 4; ++ks)
#pragma unroll
        for (int mt = 0; mt < 2; ++mt) oa[mt] = MFMA16(fy[mt * 4 + ks], Sb[ks], oa[mt]);
    bf16x8 Vb[2];
#pragma unroll
    for (int ks = 0; ks < 2; ++ks) { u32x4 w; w.x = pack2(vn[2 * ks][0], vn[2 * ks][1]); w.y = pack2(vn[2 * ks][2], vn[2 * ks][3]); w.z = pack2(vn[2 * ks + 1][0], vn[2 * ks + 1][1]); w.w = pack2(vn[2 * ks + 1][2], vn[2 * ks + 1][3]);
        Vb[ks] = __builtin_bit_cast(bf16x8, w); }
    SCAN_SB;
#pragma unroll
    for (int i = 0; i < 8; ++i) fy[i] = *(const bf16x8*)(Bl + 32768 + i * 1024);
    SCAN_SB;
#pragma unroll
    for (int ks = 0; ks < 4; ++ks)
#pragma unroll
        for (int mt = 2; mt < 4; ++mt) oa[mt] = MFMA16(fx[(mt - 2) * 4 + ks], Sb[ks], oa[mt]);
#pragma unroll
    for (int ks = 0; ks < 2; ++ks)
#pragma unroll
        for (int mt = 0; mt < 4; ++mt) oa[mt] = MFMA16(fx[8 + mt * 2 + ks], Vb[ks], oa[mt]);
    SCAN_SB;
#pragma unroll
    for (int i = 0; i < 8; ++i) fx[i] = *(const bf16x8*)(Bl + 32768 + (8 + i) * 1024);
    SCAN_SB;
#pragma unroll
    for (int m8 = 0; m8 < 4; ++m8) { f32x4 acc = Sacc[m8] * eg;
#pragma unroll
        for (int ks = 0; ks < 2; ++ks) acc = MFMA16(fy[m8 * 2 + ks], Vb[ks], acc);
        Sacc[m8] = acc; }
    SCAN_SB;
#pragma unroll
    for (int m8 = 4; m8 < 8; ++m8) { f32x4 acc = Sacc[m8] * eg;
#pragma unroll
        for (int ks = 0; ks < 2; ++ks) acc = MFMA16(fx[(m8 - 4) * 2 + ks], Vb[ks], acc);
        Sacc[m8] = acc; }
#pragma unroll
    for (int mt = 0; mt < 4; ++mt) {
        bf16_t* op = op0 + (16 * mt) * 64;
        const unsigned p0 = pack2(oa[mt][0], oa[mt][1]), p1 = pack2(oa[mt][2], oa[mt][3]);
        op[0] = (bf16_t)(p0 & 0xffffu); op[64] = (bf16_t)(p0 >> 16); op[128] = (bf16_t)(p1 & 0xffffu); op[192] = (bf16_t)(p1 >> 16);
    }
#pragma unroll
    for (int ks = 0; ks < 4; ++ks) { u32x4 w; w.x = pack2(Sacc[2 * ks][0], Sacc[2 * ks][1]); w.y = pack2(Sacc[2 * ks][2], Sacc[2 * ks][3]); w.z = pack2(Sacc[2 * ks + 1][0], Sacc[2 * ks + 1][1]); w.w = pack2(Sacc[2 * ks + 1][2], Sacc[2 * ks + 1][3]);
        Sb[ks] = __builtin_bit_cast(bf16x8, w); }
}
#undef SCAN_SB

__device__ void scan_unit(unsigned char* lds, int bh, int half, unsigned char* prep, const float* egl, const unsigned* uflag  , unsigned fval) {
    const int tid = my_tid(), lane = tid & 63, b = bh >> 2, h = bh & 3, quad = lane >> 4, cl = lane & 15;
    const int wid = __builtin_amdgcn_readfirstlane(tid >> 6);
    unsigned char* ubase = prep + (size_t)bh * 128 * PREP_UNIT;
    int ready = 0;
    (void)b; (void)h;
#define SCAN_WAIT(c) do { if ((c) < 128 && ready < (c) + 1) ready = scan_wait(lds, uflag, ready, (c) + 1, fval); } while (0)
    if (wid >= 4) {
        const int lt = tid - 256;
        u32x4 r0[14], r1[14], r2[14];
#define LD_LOAD(R, c) do { SCAN_WAIT(c); if ((c) < 128) { const unsigned char* uc_ = ubase + (size_t)(c) * PREP_UNIT; \
            _Pragma("unroll") for (int i = 0; i < 14; ++i) R[i] = *(const u32x4*)(uc_ + (size_t)(lt + 256 * i) * 16); } } while (0)
#define LD_STORE(R, c) do { if ((c) < 128) { _Pragma("unroll") for (int i = 0; i < 14; ++i) *(u32x4*)(lds + ((c) & 1) * 57344 + (size_t)(lt + 256 * i) * 16) = R[i]; } } while (0)
#define LD_STEP(n, RL, RS) do { if ((n) < 128) { LD_LOAD(RL, (n) + 3); LD_STORE(RS, (n) + 1); __syncthreads(); } } while (0)
        LD_LOAD(r0, 0); LD_LOAD(r1, 1); LD_LOAD(r2, 2);
        LD_STORE(r0, 0);
        __syncthreads();
        for (int n = 0; n < 128; n += 3) { LD_STEP(n, r0, r1); LD_STEP(n + 1, r1, r2); LD_STEP(n + 2, r2, r0); }
#undef LD_LOAD
#undef LD_STORE
#undef LD_STEP
    } else {
        const int col0 = half * 64 + wid * 16;
        f32x4 Sacc[8]; bf16x8 Sb[4];
#pragma unroll
        for (int i = 0; i < 8; ++i) Sacc[i] = (f32x4){0.f, 0.f, 0.f, 0.f};
#pragma unroll
        for (int i = 0; i < 4; ++i) Sb[i] = (bf16x8){0, 0, 0, 0, 0, 0, 0, 0};
        u32x2 r0u[4], r1u[4], r2u[4]; float r0e = 0.f, r1e = 0.f, r2e = 0.f;
#pragma unroll
        for (int mt = 0; mt < 4; ++mt) { r0u[mt] = (u32x2){0u, 0u}; r1u[mt] = (u32x2){0u, 0u}; r2u[mt] = (u32x2){0u, 0u}; }
#define CP_LOAD(R, c) do { SCAN_WAIT(c); if ((c) < 128) { const unsigned char* uc_ = ubase + (size_t)(c) * PREP_UNIT; \
            _Pragma("unroll") for (int mt = 0; mt < 4; ++mt) R##u[mt] = *(const u32x2*)(uc_ + 57344 + ((size_t)(col0 + cl) * 64 + 16 * mt + quad * 4) * 2); R##e = egl[bh * 128 + (c)]; } } while (0)
#define CP_STEP(n, R) do { if ((n) < 128) { \
            u32x2 cu_[4]; _Pragma("unroll") for (int mt = 0; mt < 4; ++mt) cu_[mt] = R##u[mt]; const float ce_ = R##e; \
            CP_LOAD(R, (n) + 3); \
            scan_compute(lds + ((n) & 1) * 57344, cu_, ce_, Sacc, Sb, (bf16_t*)(ubase + (size_t)(n) * PREP_UNIT + 57344 + half * 8192) + (quad * 4) * 64 + wid * 16 + cl, lane); \
            __syncthreads(); } } while (0)
        CP_LOAD(r0, 0); CP_LOAD(r1, 1); CP_LOAD(r2, 2);
        __syncthreads();
        for (int n = 0; n < 128; n += 3) { CP_STEP(n, r0); CP_STEP(n + 1, r1); CP_STEP(n + 2, r2); }
#undef CP_LOAD
#undef CP_STEP
    }
#undef SCAN_WAIT
}

template <int MODE>
__device__ void attn_unit(unsigned char* lds, int b, int qb, const bf16_t* Qp, const bf16_t* Kp, const bf16_t* Vp, int ld, bf16_t* Op, int ldo, const float* Fbh, const float* reltab, const float* knsuf, const unsigned* fflag, unsigned fval) {
    const int tid = my_tid(), wid = tid >> 6, lane = tid & 63, quad = lane >> 4, cl = lane & 15;
    const size_t rowbase = (size_t)b * SEQ; const int q0 = qb * 256, qw0 = q0 + 32 * wid, cq = qw0 >> 6;
    float* fkb = (float*)(lds + 36864); float* ext = (float*)(lds + 37376);
    const int kt0 = MODE == 0 ? 0 : (q0 / 64 - 8 > 0 ? q0 / 64 - 8 : 0), kt1 = q0 / 64 + 3;
    handoff_wait_one(fflag, fval);
    const float Fref = MODE == 0 ? Fbh[q0] : 0.f;
    float* ktab = (float*)(lds + 40960); float* ftab = (float*)(lds + 41472); volatile int* flags = (volatile int*)(lds + 41984);
    const int nt = kt1 - kt0 + 1;
    if (MODE == 0) { for (int i = tid; i <= kt1; i += NTHR) { ktab[i] = knsuf[i]; ftab[i] = (Fref - Fbh[64 * i + 63]) * LOG2E; } }
    if (MODE == 1) { for (int i = tid; i < 640; i += NTHR) { int rel = 575 - i; rel = rel < -63 ? -63 : (rel > 256 ? 256 : rel); ext[i] = reltab[rel + 63] * LOG2E; } }
    bf16x8 qf[2][2];
#pragma unroll
    for (int nq = 0; nq < 2; ++nq)
#pragma unroll
        for (int ks = 0; ks < 2; ++ks) qf[nq][ks] = *(const bf16x8*)(Qp + (rowbase + qw0 + 16 * nq + cl) * ld + 32 * ks + quad * 8);
    float mrun[2] = {-1e30f, -1e30f}, lrun[2] = {0.f, 0.f};
    float qn[2] = {0.f, 0.f};
    {
#pragma unroll
        for (int nq = 0; nq < 2; ++nq) { float ss = 0.f;
#pragma unroll
            for (int ks = 0; ks < 2; ++ks)
#pragma unroll
                for (int j = 0; j < 8; ++j) { const float f = __uint_as_float(((unsigned)(unsigned short)qf[nq][ks][j]) << 16); ss += f * f; }
            ss += __shfl_xor(ss, 16); ss += __shfl_xor(ss, 32); qn[nq] = sqrtf(ss) * 1.0001f; }
    }
    bool done = false;
    float Rref[2] = {0.f, 0.f};
    if (MODE == 1) { const float ka = knsuf[0], bm = knsuf[1]; Rref[0] = qn[0] * ka + bm + 1.0f; Rref[1] = qn[1] * ka + bm + 1.0f; }
    else {
#pragma unroll
        for (int nq = 0; nq < 2; ++nq) { const int qrow = qw0 + 16 * nq + cl; Rref[nq] = qn[nq] * knsuf[qrow >> 6] + (Fref - Fbh[qrow]) * LOG2E + 1.0f; }
    }
    f32x4 o[4][2];
#pragma unroll
    for (int dt = 0; dt < 4; ++dt)
#pragma unroll
        for (int nq = 0; nq < 2; ++nq) o[dt][nq] = (f32x4){0.f, 0.f, 0.f, 0.f};
    const int skey = tid >> 3, sdch = tid & 7;
    const int vkey = tid & 63, vdch = tid >> 6;
    const int vpos = (vkey & 32) + ((vkey >> 2) & 3) * 8 + ((vkey >> 4) & 1) * 4 + (vkey & 3);
    u32x4 rk0, rv0, rk1, rv1, rk2, rv2; float rf0 = 0.f, rf1 = 0.f, rf2 = 0.f;
#define ATT_TILE(r) (MODE == 0 ? kt1 - (r) : kt0 + (r))
#define ATT_LOAD(S, r) do { if ((r) < nt) { const int t_ = ATT_TILE(r); rk##S = *(const u32x4*)(Kp + (rowbase + (size_t)t_ * 64 + skey) * ld + sdch * 8); rv##S = *(const u32x4*)(Vp + (rowbase + (size_t)t_ * 64 + vkey) * ld + vdch * 8); \
        if (MODE == 0 && tid < 64) rf##S = Fbh[t_ * 64 + tid]; } } while (0)
#define ATT_STORE(S, r) do { if ((r) < nt) { const int nb_ = (r) & 1; *(u32x4*)(lds + nb_ * 9216 + skey * 144 + sdch * 16) = rk##S; \
        bf16_t* vt_ = (bf16_t*)(lds + 18432 + nb_ * 9216); \
        _Pragma("unroll") for (int i = 0; i < 8; ++i) vt_[(vdch * 8 + i) * 72 + vpos] = (bf16_t)((rv##S[i >> 1] >> (16 * (i & 1))) & 0xffffu); \
        if (MODE == 0 && tid < 64) fkb[nb_ * 64 + tid] = (Fref - rf##S) * LOG2E; } } while (0)
    auto compute = [&](const int buf, const int kt) {
            const unsigned char* Kb = lds + buf * 9216; const unsigned char* Vb = lds + 18432 + buf * 9216;
            f32x4 s[2][4];
            bf16x8 kf[4][2];
#pragma unroll
            for (int mt = 0; mt < 4; ++mt) { kf[mt][0] = *(const bf16x8*)(Kb + (16 * mt + cl) * 144 + quad * 16); kf[mt][1] = *(const bf16x8*)(Kb + (16 * mt + cl) * 144 + 64 + quad * 16); }
#pragma unroll
            for (int mt = 0; mt < 4; ++mt)
#pragma unroll
                for (int nq = 0; nq < 2; ++nq) {
                    f32x4 c;
                    if (MODE == 0) { c = *(const f32x4*)(fkb + buf * 64 + 16 * mt + quad * 4); c = c - Rref[nq]; }
                    else { const int qi = (qw0 + 16 * nq + cl) & 63, idx0 = (kt - (cq - 8)) * 64 + 16 * mt + quad * 4 + 63 - qi; c[0] = ext[idx0] - Rref[nq]; c[1] = ext[idx0 + 1] - Rref[nq]; c[2] = ext[idx0 + 2] - Rref[nq]; c[3] = ext[idx0 + 3] - Rref[nq]; }
                    s[nq][mt] = c;
                }
            __builtin_amdgcn_sched_barrier(0);
#pragma unroll
            for (int mt = 0; mt < 4; ++mt)
#pragma unroll
                for (int nq = 0; nq < 2; ++nq) { s[nq][mt] = MFMA16(kf[mt][0], qf[nq][0], s[nq][mt]); s[nq][mt] = MFMA16(kf[mt][1], qf[nq][1], s[nq][mt]); }
            bf16x8 vf[4][2];
#pragma unroll
            for (int dt = 0; dt < 4; ++dt)
#pragma unroll
                for (int ks = 0; ks < 2; ++ks) vf[dt][ks] = *(const bf16x8*)(Vb + (16 * dt + cl) * 144 + ks * 64 + quad * 16);
            __builtin_amdgcn_sched_barrier(0);
            if (MODE == 0 && (64 * kt + 63 > qw0)) {
#pragma unroll
                for (int nq = 0; nq < 2; ++nq) { const int qrow = qw0 + 16 * nq + cl;
#pragma unroll
                    for (int mt = 0; mt < 4; ++mt)
#pragma unroll
                        for (int j = 0; j < 4; ++j) if (64 * kt + 16 * mt + quad * 4 + j > qrow) s[nq][mt][j] = -1e30f; }
            }
            bf16x8 pf[2][2];
#pragma unroll
            for (int nq = 0; nq < 2; ++nq) {
                if (true) {
                    float ps = 0.f;
#pragma unroll
                    for (int mt = 0; mt < 4; ++mt)
#pragma unroll
                        for (int j = 0; j < 4; ++j) { const float pv = __builtin_amdgcn_exp2f(s[nq][mt][j]); s[nq][mt][j] = pv; ps += pv; }
                    lrun[nq] += ps;
#pragma unroll
                    for (int ks = 0; ks < 2; ++ks) { u32x4 w; w.x = pack2(s[nq][2 * ks][0], s[nq][2 * ks][1]); w.y = pack2(s[nq][2 * ks][2], s[nq][2 * ks][3]); w.z = pack2(s[nq][2 * ks + 1][0], s[nq][2 * ks + 1][1]); w.w = pack2(s[nq][2 * ks + 1][2], s[nq][2 * ks + 1][3]);
                        pf[nq][ks] = __builtin_bit_cast(bf16x8, w); }
                    continue;
                }
                float mx = s[nq][0][0];
#pragma unroll
                for (int mt = 0; mt < 4; ++mt)
#pragma unroll
                    for (int j = 0; j < 4; ++j) mx = fmaxf(mx, s[nq][mt][j]);
                mx = fmaxf(mx, __shfl_xor(mx, 16)); mx = fmaxf(mx, __shfl_xor(mx, 32));
                const float mnew = fmaxf(mrun[nq], mx), alpha = __builtin_amdgcn_exp2f(mrun[nq] - mnew);
                mrun[nq] = mnew;
                float ps = 0.f;
#pragma unroll
                for (int mt = 0; mt < 4; ++mt)
#pragma unroll
                    for (int j = 0; j < 4; ++j) { const float pv = __builtin_amdgcn_exp2f(s[nq][mt][j] - mnew); s[nq][mt][j] = pv; ps += pv; }
                lrun[nq] = lrun[nq] * alpha + ps;
#pragma unroll
                for (int dt = 0; dt < 4; ++dt) o[dt][nq] = o[dt][nq] * alpha;
#pragma unroll
                for (int ks = 0; ks < 2; ++ks) { u32x4 w; w.x = pack2(s[nq][2 * ks][0], s[nq][2 * ks][1]); w.y = pack2(s[nq][2 * ks][2], s[nq][2 * ks][3]); w.z = pack2(s[nq][2 * ks + 1][0], s[nq][2 * ks + 1][1]); w.w = pack2(s[nq][2 * ks + 1][2], s[nq][2 * ks + 1][3]);
                    pf[nq][ks] = __builtin_bit_cast(bf16x8, w); }
            }
#pragma unroll
            for (int dt = 0; dt < 4; ++dt)
#pragma unroll
                for (int ks = 0; ks < 2; ++ks) { o[dt][0] = MFMA16(vf[dt][ks], pf[0][ks], o[dt][0]); o[dt][1] = MFMA16(vf[dt][ks], pf[1][ks], o[dt][1]); }
    };
#define ATT_STEP(r, SL, SS) do { if ((r) < nt && !done) { ATT_LOAD(SL, (r) + 3); const int kt_ = ATT_TILE(r); \
        const bool act_ = MODE == 0 ? (64 * kt_ <= qw0 + 31) : (kt_ >= cq - 8 && kt_ <= cq); \
        if (act_) compute((r) & 1, kt_); \
        if (MODE == 0) { bool c_ = true; if (kt_ >= 1) { const float kb_ = ktab[kt_ - 1], fb_ = ftab[kt_ - 1] + 1.0f; c_ = (qn[0] * kb_ + fb_ < Rref[0] - 152.0f) && (qn[1] * kb_ + fb_ < Rref[1] - 152.0f); } \
            const int v_ = __all(c_ ? 1 : 0); if (lane == 0) flags[((r) & 1) * 8 + wid] = v_; } \
        ATT_STORE(SS, (r) + 1); __syncthreads(); \
        if (MODE == 0) { int a_ = 1; _Pragma("unroll") for (int w_ = 0; w_ < 8; ++w_) a_ &= (flags[((r) & 1) * 8 + w_] != 0); done = (a_ != 0); } } } while (0)
    ATT_LOAD(0, 0); ATT_LOAD(1, 1); ATT_LOAD(2, 2);
    ATT_STORE(0, 0);
    __syncthreads();
    for (int r = 0; r < nt && !done; r += 3) {
        ATT_STEP(r, 0, 1);
        ATT_STEP(r + 1, 1, 2);
        ATT_STEP(r + 2, 2, 0);
    }
#undef ATT_TILE
#undef ATT_LOAD
#undef ATT_STORE
#undef ATT_STEP
#pragma unroll
    for (int nq = 0; nq < 2; ++nq) {
        float l = lrun[nq]; l += __shfl_xor(l, 16); l += __shfl_xor(l, 32);
        const float inv = 1.0f / l;
        bf16_t* op = Op + (rowbase + qw0 + 16 * nq + cl) * ldo + quad * 4;
#pragma unroll
        for (int dt = 0; dt < 4; ++dt) { u32x2 w; w.x = pack2(o[dt][nq][0] * inv, o[dt][nq][1] * inv); w.y = pack2(o[dt][nq][2] * inv, o[dt][nq][3] * inv); *(u32x2*)(op + 16 * dt) = w; }
    }
}

#ifndef REP_SCAN
#define REP_SCAN 1
#endif
#ifndef REP_A
#define REP_A 1
#endif
#ifndef REP_FOX
#define REP_FOX 1
#endif
constexpr int LDS_SLOT = 156672, LDS_TOTAL = 156688;
constexpr int PH_PER_LAYER = 8, N_PHASES = 1 + DEPTH * PH_PER_LAYER + 1;

__device__ __forceinline__ int fetch_item(unsigned* ctr, unsigned char* lds) {
    volatile int* slot = (volatile int*)(lds + LDS_SLOT);
    __syncthreads();
    if (my_tid() == 0) *slot = (int)atomicAdd(ctr, 1u);
    __syncthreads();
    return *slot;
}

template <class Epi>
__device__ __forceinline__ void run_gemm(unsigned char* lds, const bf16_t* A, const bf16_t* Bt, int M, int N, int K, const Epi& E) {
    pg8::Gemm g{A, Bt, M, N, K}; pg8::StaticOrder S; S.init(M, N, my_gdim(), my_bid());
    pg8::gemm_phase<Epi, pg8::StaticOrder, true, true>((PG8_LAS unsigned char*)lds, g, S, E);
    __syncthreads();
}

__device__ void run_phase(const Params& p, unsigned char* lds, int ph) {
    unsigned char* ws = p.ws;
    float* xs = p.out;
    float* modp = (float*)(ws + WS_MOD);
    bf16_t* hbuf = (bf16_t*)(ws + WS_HBUF);
    if (ph == 0) { phase_prologue(p, lds); return; }
    if (ph == N_PHASES - 1) { phase_final_norm(xs, p.in[I_FNG], p.out); return; }
    const int l = (ph - 1) / PH_PER_LAYER, s = (ph - 1) % PH_PER_LAYER;
    const float* modl = modp + (size_t)l * 4 * 6144;
    const float* xin = (l == 0) ? p.in[I_X] : xs;
    switch (s) {
#ifndef NO_NORM
    case 0:
        phase_norm(p, lds, xin, p.in[I_NMG] + l * DM, modl, 0, 1024, hbuf, (const float*)(ws + WS_WSC) + (size_t)l * 12 * DM, (float*)(ws + WS_SCAL));
        break;
#endif
#ifndef NO_G1
    case 1: {
        pg8::EpiProj E{(bf16_t*)(ws + WS_PAB), (bf16_t*)(ws + WS_PC), (bf16_t*)(ws + WS_PZ)};
        run_gemm(lds, hbuf, (const bf16_t*)(ws + WS_WTIN) + (size_t)l * NPROJ * DM, MTOK, NPROJ, DM, E);
        break; }
#endif
#ifndef NO_MIX
    case 2: {
        unsigned* ctr = (unsigned*)(ws + WS_CTRL) + 8 + l;
        unsigned* uflag = (unsigned*)(ws + WS_FLG); const unsigned fval = (unsigned)l + 1u;
        const bf16_t* pab = (const bf16_t*)(ws + WS_PAB);
        for (;;) {
            const int it = fetch_item(ctr, lds);
            if (it >= 3120) break;
            if (it < 16) { const int bh = it;
                fcum_unit(lds, bh, (const float*)(ws + WS_SCAL), p.in[I_FGB] + l * 4, (float*)(ws + WS_F) , (const bf16_t*)(ws + WS_PAB) + (size_t)(bh >> 2) * SEQ * 1536 + 1024 + (bh & 3) * 64, (float*)(ws + WS_KN) + bh * 128, (const bf16_t*)(ws + WS_PAB) + (size_t)(bh >> 2) * SEQ * 1536 + 256 + (bh & 3) * 64, p.in[I_REL] + (size_t)(l * 4 + (bh & 3)) * 320, (float*)(ws + WS_AB) + bh * 2, uflag + 2048 + bh, fval); }
            else if (it < 48) { const int j = it - 16;
                for (int rep = 0; rep < REP_SCAN; ++rep) { scan_unit(lds, j >> 1, j & 1, ws + WS_PREP, (const float*)(ws + WS_EGL), uflag + (j >> 1) * 128, fval); __syncthreads(); } }
            else if (it < 2096) { const int j = it - 48, n = j >> 4, bh = j & 15, h = bh & 3;
                prep_unit(lds, bh, n, (const bf16_t*)(ws + WS_PC), (const float*)(ws + WS_SCAL), p.in[I_CONVW] + (size_t)l * 4 * 1536, p.in[I_ALOG][l * 4 + h], p.in[I_DTB][l * 4 + h],
                          ws + WS_PREP + (size_t)(bh * 128 + n) * PREP_UNIT, (float*)(ws + WS_EGL), uflag + bh * 128 + n, fval); }
            else if (it < 2608) { const int j = it - 2096, qb = j & 31, bh = j >> 5, b = bh >> 2, h = bh & 3;
                for (int rep = 0; rep < REP_A; ++rep) { attn_unit<1>(lds, b, qb, pab + h * 64, pab + 256 + h * 64, pab + 512 + h * 64, 1536, hbuf + h * 64, DM, nullptr, p.in[I_REL] + (size_t)(l * 4 + h) * 320, (const float*)(ws + WS_AB) + bh * 2, uflag + 2048 + bh, fval); __syncthreads(); } }
            else { const int j = it - 2608, qb = 31 - (j >> 4), bh = j & 15, b = bh >> 2, h = bh & 3;
                for (int rep = 0; rep < REP_FOX; ++rep) { attn_unit<0>(lds, b, qb, pab + 768 + h * 64, pab + 1024 + h * 64, pab + 1280 + h * 64, 1536, hbuf + 256 + h * 64, DM, (const float*)(ws + WS_F) + (size_t)bh * SEQ, nullptr, (const float*)(ws + WS_KN) + bh * 128, uflag + 2048 + bh, fval); __syncthreads(); } }
        }
        break; }
#endif
#ifndef NO_FIN
    case 3:
        phase_finalize(ws + WS_PREP, (const bf16_t*)(ws + WS_PZ), p.in[I_GNG] + l * 128, hbuf);
        break;
#endif
#ifndef NO_G2
    case 4: {
        pg8::EpiRes E{xin, xs, modl + 2048, 0};
        run_gemm(lds, hbuf, (const bf16_t*)(ws + WS_WTOUT) + (size_t)l * DM * DM, MTOK, DM, DM, E);
        break; }
#endif
#ifndef NO_NORM
    case 5:
        phase_norm(p, lds, xs, p.in[I_NFG] + l * DM, modl, 3072, 4096, hbuf, nullptr, nullptr);
        break;
#endif
#ifndef NO_G3
    case 6: {
        pg8::EpiAct E{(bf16_t*)(ws + WS_ACT), p.in[I_FCW] + (size_t)l * 3 * NUP, (float*)(ws + WS_HALO), (float*)(lds + 131072)};
        run_gemm(lds, hbuf, (const bf16_t*)(ws + WS_WTUP) + (size_t)l * NUP * DM, MTOK, NUP, DM, E);
        break; }
#endif
#ifndef NO_G4
    case 7: {
        { pg8::StaticOrder S0; S0.init(MTOK, DM, my_gdim(), my_bid()); pg8::Unit u0; int lastpm = -1;
          for (int i = 0; S0.next(i, u0); ++i) if (u0.pm != lastpm) { fix_panel((const float*)(ws + WS_HALO), p.in[I_FCW] + (size_t)l * 3 * NUP, (bf16_t*)(ws + WS_ACT), u0.pm); lastpm = u0.pm; }
          asm volatile("s_waitcnt vmcnt(0)" ::: "memory"); __syncthreads(); }
        pg8::EpiRes E{xs, xs, modl + 5120, 0};
        run_gemm(lds, (const bf16_t*)(ws + WS_ACT), (const bf16_t*)(ws + WS_WTDN) + (size_t)l * DM * DFF, MTOK, DM, DFF, E);
        break; }
#endif
    }
}

__global__ void __launch_bounds__(NTHR, 2) hybrid_fwd(Params p) {
    extern __shared__ __attribute__((aligned(16))) unsigned char lds[];
    volatile LAS unsigned* st_ = (volatile LAS unsigned*)(lds + LDS_SLOT + 8);
    if (threadIdx.x == 0) { st_[0] = 0u; st_[1] = 0u; }
    __syncthreads();
    (void)xcd_barrier_post((unsigned*)(p.ws + WS_XB), st_);
#ifdef PROBE_SYNC
    cg::this_grid().sync();
    for (int i = 0; i < PROBE_SYNC; ++i) { XcdBarrier xb; xb.bar = (unsigned*)(p.ws + WS_XB); xb.x = xb_xcc_id(); xb.st = st_; xcd_barrier(xb); }
#endif
    for (int ph = p.ph_lo; ph < p.ph_hi; ++ph) {
        Params q = p;
#pragma unroll
        for (int i = 0; i < 18; ++i) asm volatile("" : "+s"(q.in[i]));
        asm volatile("" : "+s"(q.out), "+s"(q.ws));
#ifdef PROBE_MASK
        const unsigned long long t0_ = __builtin_amdgcn_s_memrealtime();
#endif
        run_phase(q, lds, ph);
        if (ph + 1 < p.ph_hi) { if (p.ph_hi > 4096) cg::this_grid().sync();
            else { XcdBarrier xb; xb.bar = (unsigned*)(q.ws + WS_XB); xb.x = xb_xcc_id(); xb.st = (volatile LAS unsigned*)(lds + LDS_SLOT + 8); xcd_barrier(xb); } }
#ifdef PROBE_MASK
        if ((PROBE_MASK >> ph) & 1ull) { const unsigned long long t1_ = __builtin_amdgcn_s_memrealtime(); while (__builtin_amdgcn_s_memrealtime() - t1_ < (t1_ - t0_)) __builtin_amdgcn_s_sleep(8); }
#endif
    }
}

#ifndef N_LAUNCH_MODE
#define N_LAUNCH_MODE 1
#endif

extern "C" void kernel_launch(void* const* d_in, const int* in_sizes, int n_in, void* d_out, int out_size, void* d_ws, size_t ws_size, hipStream_t stream) {
    static int grid = 0;
    if (grid == 0) {
        if (n_in != 18 || out_size != MTOK * DM || ws_size < WS_END) { fprintf(stderr, "kernel_launch: unexpected shapes (n_in %d out %d ws %zu)\n", n_in, out_size, ws_size); grid = -1; return; }
        int dev = 0, cus = 0, per_cu = 0;
        hipGetDevice(&dev); hipDeviceGetAttribute(&cus, hipDeviceAttributeMultiprocessorCount, dev);
        if (hipFuncSetAttribute((const void*)hybrid_fwd, hipFuncAttributeMaxDynamicSharedMemorySize, LDS_TOTAL) != hipSuccess) { fprintf(stderr, "kernel_launch: hipFuncSetAttribute failed\n"); grid = -1; return; }
        if (hipOccupancyMaxActiveBlocksPerMultiprocessor(&per_cu, (const void*)hybrid_fwd, NTHR, LDS_TOTAL) != hipSuccess || per_cu < 1) { fprintf(stderr, "kernel_launch: occupancy query gave %d\n", per_cu); (void)hipGetLastError(); per_cu = 1; }
        grid = cus;
        if (grid <= 0) { grid = -1; return; }
    }
    if (grid < 0) return;
    if (hipMemsetAsync((char*)d_ws + WS_FLG, 0, (WS_XB - WS_FLG) + XCD_BAR_WORDS * 4, stream) != hipSuccess) { fprintf(stderr, "kernel_launch: memset failed\n"); return; }
    Params p{};
    for (int i = 0; i < 18; ++i) p.in[i] = (const float*)d_in[i];
    p.out = (float*)d_out; p.ws = (unsigned char*)d_ws;
#if N_LAUNCH_MODE == 1
    p.ph_lo = 0; p.ph_hi = N_PHASES;
    void* args[] = {&p};
    hipError_t e = hipLaunchCooperativeKernel((const void*)hybrid_fwd, dim3(grid), dim3(NTHR), args, LDS_TOTAL, stream);
    if (e != hipSuccess) fprintf(stderr, "kernel_launch: cooperative launch failed: %s (grid %d)\n", hipGetErrorString(e), grid);
#else
    for (int ph = 0; ph < N_PHASES; ++ph) { p.ph_lo = ph; p.ph_hi = ph + 1; hipLaunchKernelGGL(hybrid_fwd, dim3(grid), dim3(NTHR), LDS_TOTAL, stream, p); }
#endif
}
```
